# Optimizing an MI355X kernel written in HIP

```python
import math
import jax, jax.numpy as jnp
from jax import lax
import numpy as np

D_MODEL = 1024
BATCH = 4
SEQ = 8192
DEPTH = 2

CHUNK = 64
SSD_HEADS = 8
SSD_HEAD_DIM = 64
SSD_WIDTH = SSD_HEADS * SSD_HEAD_DIM
SSD_GROUPS = 2
SSD_STATE = 128
CONV_WIDTH = 4
XBC_WIDTH = SSD_WIDTH + 2 * SSD_GROUPS * SSD_STATE
HGRN_HEADS = 4
HGRN_HEAD_DIM = 128
HGRN_WIDTH = HGRN_HEADS * HGRN_HEAD_DIM
HGRN_BLOCK = 32
MIX_WIDTH = SSD_WIDTH + HGRN_WIDTH
IN_WIDTH = SSD_WIDTH + XBC_WIDTH + SSD_HEADS + 4 * HGRN_WIDTH
N_EXPERT_GROUPS = 4
EXPERTS_PER_GROUP = 4
N_EXPERTS = N_EXPERT_GROUPS * EXPERTS_PER_GROUP
TOP_K = 2
EXPERT_DIM = 256
EPS = 1e-6

kernel_name = "hymba_ssd_hgrn2_hmoe_trunk"


def rmsnorm(x, w):
    xf = x.astype(jnp.float32)
    y = xf * lax.rsqrt(jnp.mean(xf * xf, axis=-1, keepdims=True) + EPS)
    return (y * w.astype(jnp.float32)).astype(x.dtype)


def causal_depthwise_conv(u, w, b):
    s = u.shape[1]
    up = jnp.pad(u, ((0, 0), (CONV_WIDTH - 1, 0), (0, 0)))
    out = b
    for k in range(CONV_WIDTH):
        out = out + w[k] * up[:, k:k + s]
    return out


def ssd_mixer(z, xbc, dt_raw, conv_w, conv_b, dt_bias, a_log, d_skip, norm_w):
    f32 = jnp.float32
    bsz, s, _ = z.shape
    nc = s // CHUNK
    hpg = SSD_HEADS // SSD_GROUPS
    xbc = jax.nn.silu(causal_depthwise_conv(xbc, conv_w, conv_b))
    xs, bm, cm = jnp.split(xbc, [SSD_WIDTH, SSD_WIDTH + SSD_GROUPS * SSD_STATE], axis=-1)
    xs = xs.astype(f32).reshape(bsz, nc, CHUNK, SSD_GROUPS, hpg, SSD_HEAD_DIM)
    bm = bm.astype(f32).reshape(bsz, nc, CHUNK, SSD_GROUPS, SSD_STATE)
    cm = cm.astype(f32).reshape(bsz, nc, CHUNK, SSD_GROUPS, SSD_STATE)
    dt = jax.nn.softplus(dt_raw.astype(f32) + dt_bias.astype(f32)).reshape(bsz, nc, CHUNK, SSD_GROUPS, hpg)
    a = -jnp.exp(a_log.astype(f32)).reshape(SSD_GROUPS, hpg)
    cum = jnp.cumsum(dt * a, axis=2)
    causal = jnp.tril(jnp.ones((CHUNK, CHUNK), dtype=bool))[None, None, :, :, None, None]
    seg = cum[:, :, :, None] - cum[:, :, None]
    decay = jnp.exp(jnp.where(causal, seg, -jnp.inf))
    cb = jnp.einsum('bctgn,bcsgn->bctsg', cm, bm)
    scores = cb[..., None] * decay * dt[:, :, None]
    y_intra = jnp.einsum('bctsgh,bcsghp->bctghp', scores, xs)
    decay_end = jnp.exp(cum[:, :, -1:] - cum) * dt
    states = jnp.einsum('bcsgn,bcsghp->bcghpn', bm, xs * decay_end[..., None])
    chunk_decay = jnp.exp(cum[:, :, -1])

    def step(h, inp):
        dec, st = inp
        return dec[..., None, None] * h + st, h

    h0 = jnp.zeros((bsz, SSD_GROUPS, hpg, SSD_HEAD_DIM, SSD_STATE), f32)
    _, h_prev = lax.scan(step, h0, (jnp.moveaxis(chunk_decay, 1, 0), jnp.moveaxis(states, 1, 0)))
    h_prev = jnp.moveaxis(h_prev, 0, 1)
    y_inter = jnp.einsum('bctgn,bcghpn->bctghp', cm, h_prev) * jnp.exp(cum)[..., None]
    y = y_intra + y_inter + d_skip.astype(f32).reshape(SSD_GROUPS, hpg)[..., None] * xs
    y = y.reshape(bsz, s, SSD_WIDTH) * jax.nn.silu(z.astype(f32))
    y = y.reshape(bsz, s, SSD_GROUPS, SSD_WIDTH // SSD_GROUPS)
    y = rmsnorm(y, norm_w.reshape(SSD_GROUPS, SSD_WIDTH // SSD_GROUPS))
    return y.reshape(bsz, s, SSD_WIDTH).astype(z.dtype)


def hgrn2_mixer(q, f_logit, i_in, g, lb, norm_w):
    f32 = jnp.float32
    bsz, s, _ = q.shape
    nb = s // HGRN_BLOCK
    shp = (bsz, nb, HGRN_BLOCK, HGRN_HEADS, HGRN_HEAD_DIM)
    forget = lb.astype(f32) + (1.0 - lb.astype(f32)) * jax.nn.sigmoid(f_logit.astype(f32))
    log_f = jnp.log(forget).reshape(shp)
    k = (1.0 - forget).reshape(shp)
    qf = q.astype(f32).reshape(shp)
    v = i_in.astype(f32).reshape(shp)
    b = jnp.cumsum(log_f, axis=2)
    b_ref = b[:, :, HGRN_BLOCK // 2:HGRN_BLOCK // 2 + 1]
    qs = qf * jnp.exp(b - b_ref)
    ks = k * jnp.exp(b_ref - b)
    causal = jnp.tril(jnp.ones((HGRN_BLOCK, HGRN_BLOCK), dtype=bool))
    scores = jnp.where(causal, jnp.einsum('bnthk,bnshk->bnhts', qs, ks), 0.0)
    o_intra = jnp.einsum('bnhts,bnshv->bnthv', scores, v)
    q_dec = qf * jnp.exp(b)
    k_end = k * jnp.exp(b[:, :, -1:] - b)
    blk_decay = jnp.exp(b[:, :, -1])

    def step(state, inp):
        qd, ke, vv, dec = inp
        o = jnp.einsum('bthk,bhkv->bthv', qd, state)
        state = dec[..., None] * state + jnp.einsum('bshk,bshv->bhkv', ke, vv)
        return state, o

    s0 = jnp.zeros((bsz, HGRN_HEADS, HGRN_HEAD_DIM, HGRN_HEAD_DIM), f32)
    _, o_inter = lax.scan(step, s0, (jnp.moveaxis(q_dec, 1, 0), jnp.moveaxis(k_end, 1, 0),
                                     jnp.moveaxis(v, 1, 0), jnp.moveaxis(blk_decay, 1, 0)))
    o = (o_intra + jnp.moveaxis(o_inter, 0, 1)).reshape(bsz, s, HGRN_HEADS, HGRN_HEAD_DIM)
    o = rmsnorm(o, norm_w.reshape(HGRN_HEADS, HGRN_HEAD_DIM)).reshape(bsz, s, HGRN_WIDTH)
    return (o * jax.nn.silu(g.astype(f32))).astype(q.dtype)


def hier_moe(h, router_group, router_expert, w_gate, w_up, w_down):
    f32 = jnp.float32
    bsz, s, d = h.shape
    t = h.reshape(-1, d)
    p_group = jax.nn.softmax((t @ router_group).astype(f32), axis=-1)
    g_idx = jnp.argmax(p_group, axis=-1)
    g_w = jnp.max(p_group, axis=-1)
    logits = (t @ router_expert).astype(f32).reshape(-1, N_EXPERT_GROUPS, EXPERTS_PER_GROUP)
    in_group = jnp.take_along_axis(logits, g_idx[:, None, None], axis=1)[:, 0]
    top_w, top_i = lax.top_k(jax.nn.softmax(in_group, axis=-1), TOP_K)
    top_w = top_w / jnp.sum(top_w, axis=-1, keepdims=True)
    expert_id = g_idx[:, None] * EXPERTS_PER_GROUP + top_i
    combine = jnp.sum(jax.nn.one_hot(expert_id, N_EXPERTS, dtype=f32)
                      * (g_w[:, None] * top_w)[..., None], axis=1)

    def expert_step(acc, inp):
        wg, wu, wd, c = inp
        hid = jax.nn.silu(t @ wg) * (t @ wu)
        return acc + c[:, None].astype(t.dtype) * (hid @ wd), None

    y, _ = lax.scan(expert_step, jnp.zeros_like(t), (w_gate, w_up, w_down, combine.T))
    return y.reshape(bsz, s, d)


def setup_inputs(seed: int = 0) -> dict:
    key = jax.random.key(seed)
    ks = jax.random.split(key, 24)
    f32 = jnp.float32
    nrm = lambda k, shp, sc: jax.random.normal(k, shp, f32) * sc
    dt0 = jnp.exp(jax.random.uniform(ks[5], (DEPTH, SSD_HEADS), f32, math.log(1e-3), math.log(1e-1)))
    return {
        "x": nrm(ks[0], (BATCH, SEQ, D_MODEL), 1.0),
        "norm_mix_w": 1.0 + nrm(ks[1], (DEPTH, D_MODEL), 0.02),
        "w_in": nrm(ks[2], (DEPTH, D_MODEL, IN_WIDTH), D_MODEL ** -0.5),
        "conv_w": nrm(ks[3], (DEPTH, CONV_WIDTH, XBC_WIDTH), CONV_WIDTH ** -0.5),
        "conv_b": nrm(ks[4], (DEPTH, XBC_WIDTH), 0.02),
        "dt_bias": dt0 + jnp.log(-jnp.expm1(-dt0)),
        "a_log": jnp.log(jax.random.uniform(ks[6], (DEPTH, SSD_HEADS), f32, 1.0, 16.0)),
        "d_skip": 1.0 + nrm(ks[7], (DEPTH, SSD_HEADS), 0.1),
        "ssd_norm_w": 1.0 + nrm(ks[8], (DEPTH, SSD_WIDTH), 0.02),
        "hgrn_lb_logits": nrm(ks[9], (DEPTH, HGRN_WIDTH), 0.1),
        "hgrn_norm_w": 1.0 + nrm(ks[10], (DEPTH, HGRN_WIDTH), 0.02),
        "w_out": nrm(ks[11], (DEPTH, MIX_WIDTH, D_MODEL), MIX_WIDTH ** -0.5),
        "norm_ffn_w": 1.0 + nrm(ks[12], (DEPTH, D_MODEL), 0.02),
        "router_group": nrm(ks[13], (DEPTH, D_MODEL, N_EXPERT_GROUPS), D_MODEL ** -0.5),
        "router_expert": nrm(ks[14], (DEPTH, D_MODEL, N_EXPERTS), D_MODEL ** -0.5),
        "w_gate": nrm(ks[15], (DEPTH, N_EXPERTS, D_MODEL, EXPERT_DIM), D_MODEL ** -0.5),
        "w_up": nrm(ks[16], (DEPTH, N_EXPERTS, D_MODEL, EXPERT_DIM), D_MODEL ** -0.5),
        "w_down": nrm(ks[17], (DEPTH, N_EXPERTS, EXPERT_DIM, D_MODEL), EXPERT_DIM ** -0.5),
        "final_norm_w": 1.0 + nrm(ks[18], (D_MODEL,), 0.02),
    }


def reference(x, norm_mix_w, w_in, conv_w, conv_b, dt_bias, a_log, d_skip, ssd_norm_w,
              hgrn_lb_logits, hgrn_norm_w, w_out, norm_ffn_w, router_group, router_expert,
              w_gate, w_up, w_down, final_norm_w):
    p = jax.nn.softmax(hgrn_lb_logits.astype(jnp.float32), axis=0)
    lower_bounds = jnp.cumsum(p, axis=0) - p[0:1]
    splits = [SSD_WIDTH, SSD_WIDTH + XBC_WIDTH, SSD_WIDTH + XBC_WIDTH + SSD_HEADS]
    splits = splits + [splits[-1] + HGRN_WIDTH * j for j in (1, 2, 3)]
    for l in range(DEPTH):
        h = rmsnorm(x, norm_mix_w[l])
        proj = h @ w_in[l]
        z, xbc, dt_raw, hq, hf, hi, hg = jnp.split(proj, splits, axis=-1)
        y_ssd = ssd_mixer(z, xbc, dt_raw, conv_w[l], conv_b[l], dt_bias[l], a_log[l],
                          d_skip[l], ssd_norm_w[l])
        y_hgrn = hgrn2_mixer(hq, hf, hi, hg, lower_bounds[l], hgrn_norm_w[l])
        x = x + jnp.concatenate([y_ssd, y_hgrn], axis=-1) @ w_out[l]
        h = rmsnorm(x, norm_ffn_w[l])
        x = x + hier_moe(h, router_group[l], router_expert[l], w_gate[l], w_up[l], w_down[l])
    return rmsnorm(x, final_norm_w)
```

```cpp
#include <hip/hip_runtime.h>
#include <cstdio>
#include <cstdint>

typedef unsigned short bf16;
constexpr int T = 32768, D = 1024, SEQ = 8192, NB = 4;
constexpr int INW = 3592, PW = 3584;
constexpr float EPS = 1e-6f;
constexpr size_t MiB = 1u << 20;
constexpr size_t WS_CTL = 0, CTL_ZERO_BYTES = 1 * MiB;
constexpr size_t WS_DT = 1 * MiB;
constexpr size_t WS_SA = 2 * MiB;
constexpr size_t WS_CS = 2 * MiB + 256 * 1024;
constexpr size_t WS_SSQ = 3 * MiB;
constexpr size_t WS_TOKINFO = 5 * MiB;
constexpr size_t WS_LIST = 6 * MiB;
constexpr size_t WS_E1 = 9 * MiB;
constexpr size_t WS_BLKDEC = 10 * MiB;
constexpr size_t WS_WIN = 12 * MiB;
constexpr size_t WS_WOUT = 26 * MiB;
constexpr size_t WS_WGU = 30 * MiB;
constexpr size_t WS_WD = 62 * MiB;
constexpr size_t WS_WR = 78 * MiB;
constexpr size_t WS_WDT = 79 * MiB;
constexpr size_t WS_XB = 84 * MiB;
constexpr size_t WS_PROJ = 148 * MiB;
constexpr size_t WS_YA = 372 * MiB;
constexpr size_t WS_XQ = WS_YA;
constexpr size_t WS_YRAW = 372 * MiB;
constexpr size_t WS_BCT = 436 * MiB, WS_CC = 452 * MiB, WS_HID = 468 * MiB;

__device__ __forceinline__ float bf2f(bf16 v) { return __uint_as_float((unsigned)v << 16); }
__device__ __forceinline__ bf16 f2bf(float f) { unsigned u = __float_as_uint(f); return (bf16)((u + 0x7fffu + ((u >> 16) & 1u)) >> 16); }
__device__ __forceinline__ float rcpf(float x) { return __builtin_amdgcn_rcpf(x); }
__device__ __forceinline__ float siluf(float x) { return x * rcpf(1.f + __expf(-x)); }
__device__ __forceinline__ float sigmf(float x) { return rcpf(1.f + __expf(-x)); }
__device__ __forceinline__ float softplusf(float x) { const float e = __expf(x), u = 1.f + e; return x > 20.f ? x : (u == 1.f ? e : __logf(u) * (e * rcpf(u - 1.f))); }
__device__ __forceinline__ float wave_sum(float v) {
#pragma unroll
    for (int o = 1; o < 64; o <<= 1) v += __shfl_xor(v, o);
    return v;
}

__device__ __forceinline__ size_t perm_idx(int t, int c, int ld) {
    return (size_t)((t & ~31) + ((c & 255) >> 3)) * ld + (c & ~255) + ((t & 31) << 3) + (c & 7);
}
#define LAS __attribute__((address_space(3)))
#define GAS __attribute__((address_space(1)))
typedef short bf16x8 __attribute__((ext_vector_type(8)));
typedef float f32x4 __attribute__((ext_vector_type(4)));
typedef unsigned u32x4 __attribute__((ext_vector_type(4)));
typedef unsigned u32x2 __attribute__((ext_vector_type(2)));
typedef int i32x4 __attribute__((ext_vector_type(4)));
typedef GAS unsigned gu32;
#define RLX_AGENT __ATOMIC_RELAXED, __HIP_MEMORY_SCOPE_AGENT
#define LDS_WAIT() asm volatile("s_waitcnt lgkmcnt(0)" ::: "memory")
#define VM_WAIT() asm volatile("s_waitcnt vmcnt(0)" ::: "memory")
struct Args { const float* in[19]; float* out; unsigned char* ws; int ph_lo, ph_hi, li, pad; };
constexpr int NWAVES = 8, NTHR = 512;
constexpr int BM = 256, BK = 64, HALF = 128, HTB = HALF * BK * 2, STAGE_BYTES = 8 * HTB, NXCD = 8, WGM = 8;
constexpr int RING_BYTES = 131072, LDSCTL_OFF = RING_BYTES, MISC_OFF = LDSCTL_OFF + 320, LDS_BYTES = 147456;
constexpr int SCLT_OFF = 135936;

__host__ __device__ __forceinline__ int lds_byte(int r, int c) { const int st = (r >> 4) * 2 + (c >> 5), rr = r & 15, cc = c & 31, ob = rr * 64 + cc * 2; return st * 1024 + (ob ^ (((ob >> 9) & 1) << 5)); }
__host__ __device__ __forceinline__ void stage_rc(int b, int& R, int& C) { const int st = b / 1024, sb = b % 1024, swz = sb ^ (((sb >> 9) & 1) << 5); R = (st >> 1) * 16 + swz / 64; C = (st & 1) * 32 + (swz % 64) / 2; }
__host__ __device__ __forceinline__ int perm32(int rho) { const int n = rho >> 4, i = rho & 15; return 8 * (i >> 2) + 4 * n + (i & 3); }
typedef __bf16 bf16x2_t __attribute__((ext_vector_type(2)));
typedef float f32x2_t __attribute__((ext_vector_type(2)));
__device__ __forceinline__ unsigned cvt_pk_bf16(float lo, float hi) { const f32x2_t v = {lo, hi}; const bf16x2_t r = __builtin_convertvector(v, bf16x2_t); return __builtin_bit_cast(unsigned, r); }
__device__ __forceinline__ float bflo(unsigned w) { return __uint_as_float(w << 16); }
__device__ __forceinline__ float bfhi(unsigned w) { return __uint_as_float(w & 0xffff0000u); }

struct Unit { int pm, pn; };
struct StaticOrder {
    int nM, nN, nwg, G, c;
    __device__ void init(int M, int N, int G_, int c_) { nM = M / BM; nN = N / BM; nwg = nM * nN; G = G_; c = c_; }
    __device__ bool next(int i, Unit& u) const {
        const long L = (long)i * G + c; if (L >= nwg) return false;
        int wgid = (int)L; { const int q = nwg / NXCD, r = nwg % NXCD, xcd = wgid % NXCD, off = wgid / NXCD; wgid = (xcd < r ? xcd * (q + 1) : r * (q + 1) + (xcd - r) * q) + off; }
        const int nig = WGM * nN, gid = wgid / nig, fm = gid * WGM, gsz = (nM - fm) < WGM ? (nM - fm) : WGM;
        u.pm = fm + ((wgid % nig) % gsz); u.pn = (wgid % nig) / gsz; return true;
    }
};
template <bool KSC_, bool APERM_ = false> struct PlainProbT {
    typedef ::Unit Unit; static constexpr bool GATHER = false, KSC = KSC_, I8 = false, APERM = APERM_;
    const bf16* A; const bf16* Bt; int K, lda, ldb; StaticOrder so; const float* scl;
    __device__ __forceinline__ bool next(int i, Unit& u) const { return so.next(i, u); }
    __device__ __forceinline__ const char* a_base(const Unit& u) const { return (const char*)A + (size_t)u.pm * BM * lda * 2; }
    __device__ __forceinline__ const char* b_base(const Unit& u) const { return (const char*)Bt + (size_t)u.pn * BM * ldb * 2; }
    __device__ __forceinline__ const char* b_at(const char* cB, const Unit&, int t) const { return cB + (size_t)t * (BK * 2); }
    __device__ __forceinline__ void a_offs(const Unit&, const int (&)[2], const int (&)[2], unsigned (&)[2][2]) const {}
};
typedef PlainProbT<false> PlainProb;
struct I8Prob {
    typedef ::Unit Unit; static constexpr bool GATHER = false, KSC = false, I8 = true, APERM = false;
    const bf16* A; const bf16* Bt; int K, lda, ldb; StaticOrder so;
    __device__ __forceinline__ bool next(int i, Unit& u) const { return so.next(i, u); }
    __device__ __forceinline__ const char* a_base(const Unit& u) const { return (const char*)A + (size_t)u.pm * BM * lda * 2; }
    __device__ __forceinline__ const char* b_base(const Unit& u) const { return (const char*)Bt + (size_t)u.pn * BM * ldb * 2; }
    __device__ __forceinline__ const char* b_at(const char* cB, const Unit&, int t) const { return cB + (size_t)t * (BK * 2); }
    __device__ __forceinline__ void a_offs(const Unit&, const int (&)[2], const int (&)[2], unsigned (&)[2][2]) const {}
};

__device__ __forceinline__ float rstd_from_ssq(const float* ssq, int row) {
    const f32x4 a = *(const f32x4*)(ssq + (size_t)row * 4);
    return rsqrtf(((a[0] + a[1]) + (a[2] + a[3])) * (1.f / D) + EPS);
}
struct EpiProj {
    typedef f32x4 acc_t; static constexpr bool PERM = true;
    bf16* O; int ldc; const float* ssq;
    __device__ __forceinline__ void operator()(const f32x4 (&acc)[2][2][4][2], const Unit& u, int wr, int wc, int fr_, int fq_, LAS unsigned char*) const {
        int fr = fr_, fq = fq_; asm volatile("" : "+v"(fr), "+v"(fq));
        const int row0 = u.pm * BM + wr * 64 + fr, col0 = u.pn * BM + wc * 32 + 8 * fq;
        float rsv[2][4];
#pragma unroll
        for (int ai = 0; ai < 2; ++ai)
#pragma unroll
            for (int m = 0; m < 4; ++m) rsv[ai][m] = rstd_from_ssq(ssq, row0 + ai * HALF + m * 16);
        asm volatile("" ::: "memory");
#pragma unroll
        for (int ai = 0; ai < 2; ++ai)
#pragma unroll
            for (int m = 0; m < 4; ++m) { const int r = row0 + ai * HALF + m * 16; const float rs = rsv[ai][m]; bf16* rowp = O + (size_t)r * ldc + col0;
#pragma unroll
                for (int bj = 0; bj < 2; ++bj) { const f32x4 v0 = acc[ai][bj][m][0] * rs, v1 = acc[ai][bj][m][1] * rs;
                    u32x4 w; w.x = cvt_pk_bf16(v0[0], v0[1]); w.y = cvt_pk_bf16(v0[2], v0[3]); w.z = cvt_pk_bf16(v1[0], v1[1]); w.w = cvt_pk_bf16(v1[2], v1[3]);
                    *(u32x4*)(rowp + bj * HALF) = w; }
                asm volatile("" ::: "memory"); }
    }
};
struct EpiProjI8 {
    typedef i32x4 acc_t; static constexpr bool PERM = true;
    bf16* O; int ldc; const float* sa; const float* cs; bool nostore; bool dense;
    __device__ __forceinline__ void operator()(const i32x4 (&acc)[2][2][4][2], const Unit& u, int wr, int wc, int fr_, int fq_, LAS unsigned char*) const {
        int fr = fr_, fq = fq_; asm volatile("" : "+v"(fr), "+v"(fq));
        const int row0 = u.pm * BM + wr * 64 + fr, col0 = u.pn * BM + wc * 32 + 8 * fq;
        f32x4 c0[2][2];
#pragma unroll
        for (int bj = 0; bj < 2; ++bj)
#pragma unroll
            for (int n = 0; n < 2; ++n) c0[bj][n] = *(const f32x4*)(cs + col0 + bj * HALF + 4 * n);
        const bool gate = ((0x3003u >> u.pn) & 1u) != 0; const size_t bjstep = gate ? (size_t)16 * ldc : (size_t)HALF;
        float rsv[2][4];
#pragma unroll
        for (int ai = 0; ai < 2; ++ai)
#pragma unroll
            for (int m = 0; m < 4; ++m) rsv[ai][m] = sa[row0 + ai * HALF + m * 16];
        asm volatile("" ::: "memory");
#pragma unroll
        for (int ai = 0; ai < 2; ++ai)
#pragma unroll
            for (int m = 0; m < 4; ++m) { const int r = row0 + ai * HALF + m * 16; const float rs = rsv[ai][m]; bf16* rowp = gate ? O + perm_idx(r, col0, ldc) : O + (size_t)r * ldc + col0;
#pragma unroll
                for (int bj = 0; bj < 2; ++bj) { const i32x4 a0 = acc[ai][bj][m][0], a1 = acc[ai][bj][m][1];
                    const f32x4 v0 = (f32x4){(float)a0[0], (float)a0[1], (float)a0[2], (float)a0[3]} * c0[bj][0] * rs, v1 = (f32x4){(float)a1[0], (float)a1[1], (float)a1[2], (float)a1[3]} * c0[bj][1] * rs;
                    u32x4 w; w.x = cvt_pk_bf16(v0[0], v0[1]); w.y = cvt_pk_bf16(v0[2], v0[3]); w.z = cvt_pk_bf16(v1[0], v1[1]); w.w = cvt_pk_bf16(v1[2], v1[3]);
                    if (dense) *(u32x4*)(O + (size_t)(u.pm * 14 + u.pn) * 65536 + (size_t)(((wr * 4 + wc) * 16 + (ai * 4 + m) * 2 + bj) * 512 + (fq * 16 + fr) * 8)) = w;
                    else if (!nostore) *(u32x4*)(rowp + bj * bjstep) = w; else asm volatile("" :: "v"(w.x), "v"(w.y), "v"(w.z), "v"(w.w)); }
                asm volatile("" ::: "memory"); }
    }
};
struct EpiResid {
    typedef f32x4 acc_t; static constexpr bool PERM = true;
    bf16* X; int ldc; bool dry; const float* scl;
    __device__ __forceinline__ void operator()(const f32x4 (&acc)[2][2][4][2], const Unit& u, int wr, int wc, int fr_, int fq_, LAS unsigned char* lds) const {
        int fr = fr_, fq = fq_; asm volatile("" : "+v"(fr), "+v"(fq));
        const int row0 = u.pm * BM + wr * 64 + fr, col0 = u.pn * BM + wc * 32 + 8 * fq;
        u32x4 ov[2][4][2];
#pragma unroll
        for (int ai = 0; ai < 2; ++ai)
#pragma unroll
            for (int m = 0; m < 4; ++m)
#pragma unroll
                for (int bj = 0; bj < 2; ++bj) ov[ai][m][bj] = *(const u32x4*)(X + (size_t)(row0 + ai * HALF + m * 16) * ldc + col0 + bj * HALF);
        asm volatile("" ::: "memory");
#pragma unroll
        for (int ai = 0; ai < 2; ++ai)
#pragma unroll
            for (int m = 0; m < 4; ++m) { const int r = row0 + ai * HALF + m * 16; bf16* rowp = X + (size_t)r * ldc + col0; const float fs = scl ? ((const LAS float*)(lds + SCLT_OFF))[(wr * 64 + fr + ai * HALF + m * 16) * 8 + 5] : 1.f;
#pragma unroll
                for (int bj = 0; bj < 2; ++bj) { const u32x4 o = ov[ai][m][bj]; const f32x4 v0 = acc[ai][bj][m][0] * fs, v1 = acc[ai][bj][m][1] * fs;
                    u32x4 w; w.x = cvt_pk_bf16(bflo(o.x) + v0[0], bfhi(o.x) + v0[1]); w.y = cvt_pk_bf16(bflo(o.y) + v0[2], bfhi(o.y) + v0[3]);
                    w.z = cvt_pk_bf16(bflo(o.z) + v1[0], bfhi(o.z) + v1[1]); w.w = cvt_pk_bf16(bflo(o.w) + v1[2], bfhi(o.w) + v1[3]);
                    if (!dry) *(u32x4*)(rowp + bj * HALF) = w; else asm volatile("" :: "v"(w.x), "v"(w.y), "v"(w.z), "v"(w.w)); }
                asm volatile("" ::: "memory"); }
    }
};

__device__ __forceinline__ f32x4 ksc_calc(const float* src, int half) {
    f32x4 v[8];
#pragma unroll
    for (int i = 0; i < 8; ++i) v[i] = *(const f32x4*)(src + 4 * i);
    float q[4];
#pragma unroll
    for (int i = 0; i < 4; ++i) { const f32x4 a = v[2 * i] + v[2 * i + 1]; q[i] = (a[0] + a[1]) + (a[2] + a[3]); }
    const float sA = rsqrtf((half ? q[0] : q[0] + q[1]) * (half ? 1.f / 128.f : 1.f / 256.f) + EPS), sB = rsqrtf((half ? q[1] : q[2] + q[3]) * (half ? 1.f / 128.f : 1.f / 256.f) + EPS);
    const float sC = rsqrtf(q[2] * (1.f / 128.f) + EPS), sD = rsqrtf(q[3] * (1.f / 128.f) + EPS);
    const float n2 = __shfl_xor(sA, 1), n3 = __shfl_xor(sB, 1), n4 = __shfl_xor(sC, 1);
    const f32x4 o = half ? (f32x4){sC * __builtin_amdgcn_rcpf(sD), sD, 0.f, 0.f} : (f32x4){sA * __builtin_amdgcn_rcpf(sB), sB * __builtin_amdgcn_rcpf(n2), n2 * __builtin_amdgcn_rcpf(n3), n3 * __builtin_amdgcn_rcpf(n4)};
    return o;
}
template <bool I8> __device__ __forceinline__ f32x4 mma_any(bf16x8 a, bf16x8 b, f32x4 c) { return __builtin_amdgcn_mfma_f32_16x16x32_bf16(a, b, c, 0, 0, 0); }
template <bool I8> __device__ __forceinline__ i32x4 mma_any(bf16x8 a, bf16x8 b, i32x4 c) { return __builtin_amdgcn_mfma_i32_16x16x64_i8(__builtin_bit_cast(i32x4, a), __builtin_bit_cast(i32x4, b), c, 0, 0, 0); }
template <class Epi, class Prob, int XM = 0>
__device__ __forceinline__ void gemm_phase(LAS unsigned char* lds, const Prob& S, const Epi& E) {
    typedef typename Prob::Unit PUnit;
    int tid = threadIdx.x; asm volatile("" : "+v"(tid));
    const int wid = __builtin_amdgcn_readfirstlane(tid >> 6), lane = tid & 63, wr = wid >> 2, wc = wid & 3, fr = lane & 15, fq = lane >> 4;
    const int K = S.K, nt = K / BK;
    int R[2], C[2]; unsigned voffA[2], voffB[2];
#pragma unroll
    for (int i = 0; i < 2; ++i) { stage_rc(tid * 16 + i * 8192, R[i], C[i]); const int Rb = Epi::PERM ? ((R[i] & ~31) + perm32(R[i] & 31)) : R[i];
        voffA[i] = Prob::APERM ? (unsigned)(((R[i] & ~31) + (C[i] >> 3)) * S.lda + ((R[i] & 31) << 3)) * 2u : (unsigned)(R[i] * S.lda + C[i]) * 2u; voffB[i] = (unsigned)(Rb * S.ldb + C[i]) * 2u; }
    const size_t kstep = (size_t)(BK * 2);
#define PG8_A_AT(base, t) (Prob::APERM ? (base) + (size_t)((t) & 3) * ((size_t)8 * S.lda * 2) + (size_t)((t) >> 2) * 512 : (base) + (size_t)(t) * kstep)
    const size_t hstepA = (size_t)HALF * S.lda * 2, hstepB = (size_t)HALF * S.ldb * 2;
    const unsigned ldsw = (unsigned)wid * 1024u;
    const int aoff = lds_byte(wr * 64 + fr, fq * 8), boff = lds_byte(wc * 32 + fr, fq * 8);
#define PG8_SA(b, h) (((b) * 2 + (h)) * HTB)
#define PG8_SB(b, h) ((4 + (b) * 2 + (h)) * HTB)
#define PG8_STAGE(bufoff, gbase, voff) do { if constexpr (!(XM & 2)) _Pragma("unroll") for (int _i = 0; _i < 2; ++_i) \
        __builtin_amdgcn_global_load_lds((const unsigned*)((const char*)(gbase) + (voff)[_i]), (LAS unsigned*)(lds + (bufoff) + ldsw + _i * 8192), 16, 0, 0); } while (0)
#define PG8_STAGE_A(b, h, ptr, offs) do { if constexpr (Prob::GATHER) PG8_STAGE(PG8_SA(b, h), ptr, offs[h]); else PG8_STAGE(PG8_SA(b, h), (ptr) + (h) * hstepA, voffA); } while (0)
#define PG8_LDA(dst, b, h) do { _Pragma("unroll") for (int m = 0; m < 4; ++m) _Pragma("unroll") for (int k = 0; k < 2; ++k) dst[m][k] = *(const LAS bf16x8*)(lds + PG8_SA(b, h) + aoff + m * 2048 + k * 1024); } while (0)
#define PG8_LDB(dst, b, h) do { _Pragma("unroll") for (int n = 0; n < 2; ++n) _Pragma("unroll") for (int k = 0; k < 2; ++k) dst[n][k] = *(const LAS bf16x8*)(lds + PG8_SB(b, h) + boff + n * 2048 + k * 1024); } while (0)
#define PG8_MMA(ai, bj, At, Bt) do { __builtin_amdgcn_s_setprio(1); _Pragma("unroll") for (int m = 0; m < 4; ++m) _Pragma("unroll") for (int n = 0; n < 2; ++n) _Pragma("unroll") for (int k = 0; k < 2; ++k) \
        { if constexpr (XM & 1) asm volatile("" :: "v"(Bt[n][k]), "v"(At[m][k])); else acc[ai][bj][m][n] = mma_any<Prob::I8>(Bt[n][k], At[m][k], acc[ai][bj][m][n]); } __builtin_amdgcn_s_setprio(0); } while (0)
#define PG8_SCLCALC(u) do { if constexpr (Prob::KSC) sclv = ksc_calc(S.scl + (size_t)((u).pm * BM + (tid >> 1)) * 64 + (tid & 1) * 32, tid & 1); } while (0)
#define PG8_SCLSTORE() do { if constexpr (Prob::KSC) *(LAS f32x4*)(lds + SCLT_OFF + tid * 16) = sclv; } while (0)
#define PG8_WAIT_V(n) asm volatile("s_waitcnt vmcnt(" #n ")" ::: "memory")
#define PG8_WAIT_L(n) asm volatile("s_waitcnt lgkmcnt(" #n ")" ::: "memory")
#define PG8_BAR __builtin_amdgcn_s_barrier()
#define PG8_SCHED __builtin_amdgcn_sched_barrier(0)
    PUnit cur, nxt; int ui = 0;
    if (!S.next(0, cur)) return;
    typedef typename Epi::acc_t acc_t;
    acc_t acc[2][2][4][2];
#pragma unroll
    for (int a = 0; a < 2; ++a)
#pragma unroll
        for (int b = 0; b < 2; ++b)
#pragma unroll
            for (int m = 0; m < 4; ++m)
#pragma unroll
                for (int n = 0; n < 2; ++n) acc[a][b][m][n] = (acc_t){0, 0, 0, 0};
    bf16x8 At[4][2], B0[2][2], B1[2][2];
    unsigned aoc[2][2], aon[2][2];
    if constexpr (Prob::GATHER) S.a_offs(cur, R, C, aoc);
    const char* cA = S.a_base(cur); const char* cB = S.b_base(cur);
    f32x4 sclv = (f32x4){0.f, 0.f, 0.f, 0.f}; PG8_SCLCALC(cur); PG8_SCLSTORE();
    {
        const char* cB0 = S.b_at(cB, cur, 0); const char* cB1 = S.b_at(cB, cur, 1);
        PG8_STAGE(PG8_SB(0, 0), cB0, voffB); PG8_STAGE(PG8_SB(0, 1), cB0 + hstepB, voffB); PG8_STAGE_A(0, 0, cA, aoc); PG8_STAGE_A(0, 1, cA, aoc);
        if (wr == 1) PG8_BAR;
        PG8_WAIT_V(2); PG8_BAR;
        PG8_STAGE(PG8_SB(1, 0), cB1, voffB); PG8_STAGE_A(1, 0, PG8_A_AT(cA, 1), aoc); PG8_STAGE(PG8_SB(1, 1), cB1 + hstepB, voffB);
        PG8_WAIT_V(6); PG8_BAR;
    }
    for (;;) {
        const bool has_next = S.next(ui + 1, nxt);
        if constexpr (Prob::GATHER) {
            if (has_next) S.a_offs(nxt, R, C, aon);
            else {
#pragma unroll
                for (int h = 0; h < 2; ++h)
#pragma unroll
                    for (int i = 0; i < 2; ++i) aon[h][i] = aoc[h][i];
            }
        }
        const char* nA = has_next ? S.a_base(nxt) : cA; const char* nB = has_next ? S.b_base(nxt) : cB;
        for (int t = 0; t < nt; t += 2) {
            const bool last = (t == nt - 2);
            const char* a1 = PG8_A_AT(cA, t + 1);
            const char* a2 = last ? nA : PG8_A_AT(cA, t + 2); const char* b2 = last ? nB : S.b_at(cB, cur, t + 2);
            const char* a3 = last ? PG8_A_AT(nA, 1) : PG8_A_AT(cA, t + 3); const char* b3 = last ? nB + kstep : S.b_at(cB, cur, t + 3);
            if constexpr (Prob::KSC) {
                if ((0x5510u >> t) & 1u) { const int j = (t >> 1) - 3 + (t == 4 ? 1 : 0);
                    const LAS float* sp = (const LAS float*)(lds + SCLT_OFF) + (wr * 64 + fr) * 8 + j; float f[2][4];
#pragma unroll
                    for (int ai = 0; ai < 2; ++ai)
#pragma unroll
                        for (int m = 0; m < 4; ++m) f[ai][m] = sp[(ai * HALF + m * 16) * 8];
#pragma unroll
                    for (int ai = 0; ai < 2; ++ai)
#pragma unroll
                        for (int m = 0; m < 4; ++m)
#pragma unroll
                            for (int bj = 0; bj < 2; ++bj)
#pragma unroll
                                for (int n = 0; n < 2; ++n) acc[ai][bj][m][n] = acc[ai][bj][m][n] * f[ai][m]; }
            }
            PG8_LDB(B0, 0, 0); PG8_LDB(B1, 0, 1); PG8_SCHED; PG8_LDA(At, 0, 0); PG8_STAGE_A(1, 1, a1, aoc);
            if constexpr (Prob::GATHER) { if (last) {
#pragma unroll
                for (int h = 0; h < 2; ++h)
#pragma unroll
                    for (int i = 0; i < 2; ++i) aoc[h][i] = aon[h][i]; } }
            PG8_WAIT_V(8); PG8_WAIT_L(0); PG8_BAR; PG8_MMA(0, 0, At, B0); PG8_MMA(0, 1, At, B1); PG8_BAR; PG8_SCHED;
            PG8_LDA(At, 0, 1); PG8_STAGE(PG8_SB(0, 0), b2, voffB); PG8_STAGE(PG8_SB(0, 1), b2 + hstepB, voffB); PG8_STAGE_A(0, 0, a2, aoc);
            PG8_WAIT_V(8); PG8_WAIT_L(0); PG8_BAR; PG8_MMA(1, 0, At, B0); PG8_MMA(1, 1, At, B1); PG8_BAR; PG8_SCHED;
            PG8_LDB(B0, 1, 0); PG8_LDB(B1, 1, 1); PG8_SCHED; PG8_LDA(At, 1, 0); PG8_STAGE_A(0, 1, a2, aoc);
            PG8_WAIT_V(8); PG8_WAIT_L(0); PG8_BAR; PG8_MMA(0, 0, At, B0); PG8_MMA(0, 1, At, B1); PG8_BAR; PG8_SCHED;
            PG8_LDA(At, 1, 1); PG8_STAGE(PG8_SB(1, 0), b3, voffB); PG8_STAGE(PG8_SB(1, 1), b3 + hstepB, voffB); PG8_STAGE_A(1, 0, a3, aoc);
            PG8_WAIT_V(8); PG8_WAIT_L(0); PG8_BAR; PG8_MMA(1, 0, At, B0); PG8_MMA(1, 1, At, B1); PG8_BAR; PG8_SCHED;
        }
        if (wr == 0) PG8_BAR;
        if constexpr (XM & 4) {
#pragma unroll
            for (int a = 0; a < 2; ++a)
#pragma unroll
                for (int b = 0; b < 2; ++b)
#pragma unroll
                    for (int m = 0; m < 4; ++m)
#pragma unroll
                        for (int n = 0; n < 2; ++n) asm volatile("" :: "v"(acc[a][b][m][n]));
        } else { if (has_next) PG8_SCLCALC(nxt);
            E(acc, cur, wr, wc, fr, fq, lds); }
        if (!has_next) break;
        if constexpr (Prob::KSC) { PG8_WAIT_L(0); PG8_BAR; }
        PG8_SCLSTORE();
#pragma unroll
        for (int a = 0; a < 2; ++a)
#pragma unroll
            for (int b = 0; b < 2; ++b)
#pragma unroll
                for (int m = 0; m < 4; ++m)
#pragma unroll
                    for (int n = 0; n < 2; ++n) acc[a][b][m][n] = (acc_t){0, 0, 0, 0};
        cur = nxt; cA = nA; cB = nB; ++ui;
        if (wr == 1) PG8_BAR;
    }
    PG8_WAIT_V(0);
    PG8_BAR;
#undef PG8_STAGE_A
#undef PG8_SCLCALC
#undef PG8_SCLSTORE
#undef PG8_A_AT
#undef PG8_SA
#undef PG8_SB
#undef PG8_STAGE
#undef PG8_LDA
#undef PG8_LDB
#undef PG8_MMA
#undef PG8_WAIT_V
#undef PG8_WAIT_L
#undef PG8_BAR
#undef PG8_SCHED
}
constexpr int CW_CNT = 32768;
constexpr int LCAP = 32768;
constexpr int TBL_OFF = MISC_OFF + 128;
constexpr int PART_OFF = TBL_OFF + 256;
static_assert(PART_OFF + 4096 <= LDS_BYTES, "LDS map");

__device__ __forceinline__ void router_phase(unsigned char* ws, int l, LAS unsigned char* lds, int G) {
    int tid = threadIdx.x; asm volatile("" : "+v"(tid));
    const int lane = tid & 63, wave = __builtin_amdgcn_readfirstlane(tid >> 6);
    LAS float* lg = (LAS float*)lds + wave * 512;
    LAS int* lcnt = (LAS int*)(lds + 32768);
    const bf16* XB = (const bf16*)(ws + WS_XB); const bf16* WR = (const bf16*)(ws + WS_WR) + (size_t)l * 64 * D;
    unsigned* gcnt = (unsigned*)(ws + WS_CTL) + CW_CNT + l * 64;
    int* LIST = (int*)(ws + WS_LIST); f32x4* TOKINFO = (f32x4*)(ws + WS_TOKINFO);
    LAS unsigned char* WRS = lds + 40960;
    {
#pragma unroll
        for (int it = 0; it < 10; ++it) { const int idx = tid + 512 * it, row = idx >> 7, ch = idx & 127;
            *(LAS u32x4*)(WRS + row * 2064 + ch * 16) = *(const u32x4*)(WR + (size_t)(row < 20 ? row : 12 + row) * D + ch * 8); }
        if (tid < 129) { unsigned z; asm volatile("v_mov_b32 %0, 0" : "=v"(z)); *(LAS u32x4*)(WRS + 40 * 2064 + tid * 16) = (u32x4){z, z, z, z}; }
    }
    const int l15_ = lane & 15;
    const LAS unsigned char* brow[4] = { WRS + l15_ * 2064, WRS + (l15_ < 4 ? 16 + l15_ : 40) * 2064, WRS + (20 + l15_) * 2064, WRS + (l15_ < 4 ? 36 + l15_ : 40) * 2064 };
    for (int chunk = blockIdx.x; chunk < T / 128; chunk += G) {
        if (tid < 64) lcnt[tid] = 0;
        __syncthreads();
        const int tok0 = chunk * 128 + wave * 16;
        f32x4 acc[4];
#pragma unroll
        for (int i = 0; i < 4; ++i) acc[i] = (f32x4){0.f, 0.f, 0.f, 0.f};
        float ss = 0.f;
        const bf16* arow = XB + (size_t)(tok0 + (lane & 15)) * D + (lane >> 4) * 8;
        bf16x8 av[32];
#pragma unroll
        for (int ks = 0; ks < 32; ++ks) av[ks] = *(const bf16x8*)(arow + ks * 32);
#pragma unroll
        for (int ks = 0; ks < 32; ++ks) {
            const bf16x8 a = av[ks];
#pragma unroll
            for (int j = 0; j < 8; ++j) { const float v = bf2f((bf16)a[j]); ss += v * v; }
#pragma unroll
            for (int nt = 0; nt < 4; ++nt) { const bf16x8 b = *(const LAS bf16x8*)(brow[nt] + ks * 64 + (lane >> 4) * 16); acc[nt] = __builtin_amdgcn_mfma_f32_16x16x32_bf16(a, b, acc[nt], 0, 0, 0); }
        }
        ss += __shfl_xor(ss, 16); ss += __shfl_xor(ss, 32);
#pragma unroll
        for (int nt = 0; nt < 2; ++nt)
#pragma unroll
            for (int r = 0; r < 4; ++r) lg[(4 * (lane >> 4) + r) * 32 + nt * 16 + (lane & 15)] = acc[nt][r] + acc[nt + 2][r];
        LDS_WAIT(); asm volatile("" ::: "memory");
        int bucket = 0, pl = 0; float rs = 0.f, ca = 0.f, cb = 0.f;
        if (lane < 16) {
            rs = rsqrtf(ss * (1.f / D) + EPS);
            const LAS float* L = lg + lane * 32;
            const float g0 = L[0] * rs, g1 = L[1] * rs, g2 = L[2] * rs, g3 = L[3] * rs;
            int gi = 0; float mx = g0;
            if (g1 > mx) { mx = g1; gi = 1; } if (g2 > mx) { mx = g2; gi = 2; } if (g3 > mx) { mx = g3; gi = 3; }
            const float gw = 1.f / (__expf(g0 - mx) + __expf(g1 - mx) + __expf(g2 - mx) + __expf(g3 - mx));
            const LAS float* E4 = L + 4 + gi * 4;
            float e[4];
#pragma unroll
            for (int j = 0; j < 4; ++j) e[j] = E4[j] * rs;
            int i1 = 0; float m1 = e[0];
#pragma unroll
            for (int j = 1; j < 4; ++j) if (e[j] > m1) { m1 = e[j]; i1 = j; }
            int i2 = -1; float m2 = -3.0e38f;
#pragma unroll
            for (int j = 0; j < 4; ++j) if (j != i1 && e[j] > m2) { m2 = e[j]; i2 = j; }
            const float ex = __expf(m2 - m1), w1 = 1.f / (1.f + ex), w2 = ex * w1;
            const int pa = i1 < i2 ? i1 : i2, pb = i1 < i2 ? i2 : i1;
            ca = gw * (pa == i1 ? w1 : w2); cb = gw * (pa == i1 ? w2 : w1);
            const int pidx = pa == 0 ? pb - 1 : (pa == 1 ? pb + 1 : 5);
            bucket = gi * 6 + pidx;
            pl = __hip_atomic_fetch_add(lcnt + bucket, 1, __ATOMIC_RELAXED, __HIP_MEMORY_SCOPE_WORKGROUP);
        }
        __syncthreads();
        if (tid < 24) { const int c = lcnt[tid]; lcnt[32 + tid] = c ? (int)__hip_atomic_fetch_add(gcnt + tid, (unsigned)c, __ATOMIC_RELAXED, __HIP_MEMORY_SCOPE_AGENT) : 0; }
        __syncthreads();
        if (lane < 16) { const int pos = lcnt[32 + bucket] + pl, tok = tok0 + lane;
            LIST[(size_t)bucket * LCAP + pos] = tok; TOKINFO[tok] = (f32x4){rs, ca, cb, 0.f}; }
        __syncthreads();
    }
}

__device__ __forceinline__ void moe_table(const unsigned* gcnt, LAS int* tbl) {
    int tid = threadIdx.x; asm volatile("" : "+v"(tid));
    if (tid < 64) {
        const int c = tid < 24 ? (int)__hip_atomic_load(gcnt + tid, __ATOMIC_RELAXED, __HIP_MEMORY_SCOPE_AGENT) : 0;
        const int tiles = (c + 255) >> 8; int s = tiles;
#pragma unroll
        for (int o = 1; o < 32; o <<= 1) { const int n = __shfl_up(s, o); if (tid >= o) s += n; }
        if (tid < 24) { tbl[tid] = s - tiles; tbl[32 + tid] = c; }
        if (tid == 23) tbl[24] = s; }
    __syncthreads();
}
struct MUnit { int pm, pn, bk, r0, nv, ea, eb; };
__device__ __forceinline__ bool moe_next(const LAS int* tbl, int stride, int c, int i0, int hi, int i, MUnit& u) {
    const int L = (i + i0) * stride + c, Rtot = __builtin_amdgcn_readfirstlane(tbl[24]);
    if (L >= 4 * Rtot || L >= hi || c < 0) return false;
    const int rt = L >> 2;
    int ln = threadIdx.x & 63; asm volatile("" : "+v"(ln));
    const int tj = tbl[ln & 31], cj = tbl[32 + (ln & 31)];
    const unsigned long long mk = __ballot(ln < 24 && tj <= rt);
    const int b = 63 - __builtin_clzll(mk | 1ull);
    const int ts = __builtin_amdgcn_readlane(tj, b), cnt = __builtin_amdgcn_readlane(cj, b);
    u.pm = rt; u.pn = L & 3; u.bk = b; u.r0 = (rt - ts) * 256; u.nv = (cnt - u.r0) < 256 ? (cnt - u.r0) : 256;
    const int g = b / 6, p = b % 6; const int a = p < 3 ? 0 : (p < 5 ? 1 : 2), bb = p < 3 ? p + 1 : (p < 5 ? p - 1 : 3);
    u.ea = g * 4 + a; u.eb = g * 4 + bb; return true;
}
struct UpProb {
    typedef MUnit Unit; static constexpr bool GATHER = true, KSC = false, I8 = false, APERM = false;
    const bf16* A; const bf16* W; const int* list; const LAS int* tbl; int K, lda, ldb, G, c, i0, hi;
    __device__ __forceinline__ bool next(int i, Unit& u) const { return moe_next(tbl, G, c, i0, hi, i, u); }
    __device__ __forceinline__ const char* a_base(const Unit&) const { return (const char*)A; }
    __device__ __forceinline__ const char* b_base(const Unit& u) const { const int e = u.pn < 2 ? u.ea : u.eb; return (const char*)W + ((size_t)e * 512 + (u.pn & 1) * 256) * D * 2; }
    __device__ __forceinline__ const char* b_at(const char* cB, const Unit&, int t) const { return cB + (size_t)t * (BK * 2); }
    __device__ __forceinline__ void a_offs(const Unit& u, const int (&R)[2], const int (&C)[2], unsigned (&off)[2][2]) const {
        const int* lp = list + (size_t)u.bk * LCAP + u.r0;
#pragma unroll
        for (int h = 0; h < 2; ++h)
#pragma unroll
            for (int i = 0; i < 2; ++i) { const int row = h * HALF + R[i]; const int tok = lp[row < u.nv ? row : 0]; off[h][i] = (unsigned)tok * (unsigned)(D * 2) + (unsigned)C[i] * 2u; }
    }
};
struct DownProb {
    typedef MUnit Unit; static constexpr bool GATHER = false, KSC = false, I8 = false, APERM = false;
    const bf16* A; const bf16* W; const LAS int* tbl; int K, lda, ldb, G, c, i0, hi;
    __device__ __forceinline__ bool next(int i, Unit& u) const { return moe_next(tbl, G, c, i0, hi, i, u); }
    __device__ __forceinline__ const char* a_base(const Unit& u) const { return (const char*)A + (size_t)u.pm * BM * 512 * 2; }
    __device__ __forceinline__ const char* b_base(const Unit& u) const { return (const char*)W + ((size_t)u.ea * D + u.pn * 256) * 256 * 2; }
    __device__ __forceinline__ const char* b_at(const char* cB, const Unit& u, int t) const { return cB + (long)t * (BK * 2) + (long)(t >> 2) * (long)((u.eb - u.ea) * (D * 256 * 2) - 512); }
    __device__ __forceinline__ void a_offs(const Unit&, const int (&)[2], const int (&)[2], unsigned (&)[2][2]) const {}
};
struct EpiHid {
    typedef f32x4 acc_t; static constexpr bool PERM = false;
    bf16* H; const int* list; const f32x4* tokinfo;
    __device__ __forceinline__ void operator()(const f32x4 (&acc)[2][2][4][2], const MUnit& u, int wr, int wc, int fr_, int fq_, LAS unsigned char*) const {
        int fr = fr_, fq = fq_; asm volatile("" : "+v"(fr), "+v"(fq));
        const int* lp = list + (size_t)u.bk * LCAP + u.r0;
        const int hc0 = (u.pn >> 1) * 256 + (u.pn & 1) * 128 + 16 * wc + 4 * fq;
        int tokv[2][4]; f32x4 tiv[2][4];
#pragma unroll
        for (int ai = 0; ai < 2; ++ai)
#pragma unroll
            for (int m = 0; m < 4; ++m) { const int row = ai * HALF + wr * 64 + m * 16 + fr; tokv[ai][m] = lp[row < u.nv ? row : 0]; }
#pragma unroll
        for (int ai = 0; ai < 2; ++ai)
#pragma unroll
            for (int m = 0; m < 4; ++m) tiv[ai][m] = tokinfo[tokv[ai][m]];
        asm volatile("" ::: "memory");
#pragma unroll
        for (int ai = 0; ai < 2; ++ai)
#pragma unroll
            for (int m = 0; m < 4; ++m) { const int row = ai * HALF + wr * 64 + m * 16 + fr; const f32x4 ti = tiv[ai][m];
                const float rs = ti[0], cw = (u.pn < 2) ? ti[1] : ti[2]; bf16* rowp = H + (size_t)(u.pm * BM + row) * 512 + hc0;
#pragma unroll
                for (int bj = 0; bj < 2; ++bj) { const f32x4 g = acc[ai][bj][m][0] * rs, up = acc[ai][bj][m][1] * (rs * cw); float h[4];
#pragma unroll
                    for (int i = 0; i < 4; ++i) h[i] = siluf(g[i]) * up[i];
                    u32x2 w; w.x = cvt_pk_bf16(h[0], h[1]); w.y = cvt_pk_bf16(h[2], h[3]); *(u32x2*)(rowp + 64 * bj) = w; }
                asm volatile("" ::: "memory"); }
    }
};
struct EpiDown {
    typedef f32x4 acc_t; static constexpr bool PERM = true;
    bf16* X; const int* list; float* ssq; bool dry;
    __device__ __forceinline__ void operator()(const f32x4 (&acc)[2][2][4][2], const MUnit& u, int wr, int wc, int fr_, int fq_, LAS unsigned char* lds) const {
        int fr = fr_, fq = fq_; asm volatile("" : "+v"(fr), "+v"(fq));
        const int* lp = list + (size_t)u.bk * LCAP + u.r0; LAS float* part = (LAS float*)(lds + PART_OFF);
        const int col0 = u.pn * BM + wc * 32 + 8 * fq;
        int tokv[2][4]; u32x4 ov[2][4][2];
#pragma unroll
        for (int ai = 0; ai < 2; ++ai)
#pragma unroll
            for (int m = 0; m < 4; ++m) { const int row = ai * HALF + wr * 64 + m * 16 + fr; tokv[ai][m] = lp[row < u.nv ? row : 0]; }
#pragma unroll
        for (int ai = 0; ai < 2; ++ai)
#pragma unroll
            for (int m = 0; m < 4; ++m)
#pragma unroll
                for (int bj = 0; bj < 2; ++bj) ov[ai][m][bj] = *(const u32x4*)(X + (size_t)tokv[ai][m] * D + col0 + bj * HALF);
        asm volatile("" ::: "memory");
#pragma unroll
        for (int ai = 0; ai < 2; ++ai)
#pragma unroll
            for (int m = 0; m < 4; ++m) { const int row = ai * HALF + wr * 64 + m * 16 + fr; const bool valid = row < u.nv; const int tok = tokv[ai][m];
                bf16* rowp = X + (size_t)tok * D + col0; float s = 0.f;
#pragma unroll
                for (int bj = 0; bj < 2; ++bj) { const u32x4 o = ov[ai][m][bj]; const f32x4 v0 = acc[ai][bj][m][0], v1 = acc[ai][bj][m][1];
                    u32x4 w; w.x = cvt_pk_bf16(bflo(o.x) + v0[0], bfhi(o.x) + v0[1]); w.y = cvt_pk_bf16(bflo(o.y) + v0[2], bfhi(o.y) + v0[3]);
                    w.z = cvt_pk_bf16(bflo(o.z) + v1[0], bfhi(o.z) + v1[1]); w.w = cvt_pk_bf16(bflo(o.w) + v1[2], bfhi(o.w) + v1[3]);
                    if (valid && !dry) *(u32x4*)(rowp + bj * HALF) = w;
                    s += (bflo(w.x) * bflo(w.x) + bfhi(w.x) * bfhi(w.x)) + (bflo(w.y) * bflo(w.y) + bfhi(w.y) * bfhi(w.y))
                       + (bflo(w.z) * bflo(w.z) + bfhi(w.z) * bfhi(w.z)) + (bflo(w.w) * bflo(w.w) + bfhi(w.w) * bfhi(w.w)); }
                s += __shfl_xor(s, 16); s += __shfl_xor(s, 32);
                if (fq == 0) part[row * 4 + wc] = s;
                asm volatile("" ::: "memory"); }
        LDS_WAIT(); __builtin_amdgcn_s_barrier(); asm volatile("" ::: "memory");
        int row = threadIdx.x; asm volatile("" : "+v"(row));
        if (row < u.nv && !dry) { const f32x4 p = *(const LAS f32x4*)(part + row * 4); ssq[(size_t)lp[row] * 4 + u.pn] = (p[0] + p[1]) + (p[2] + p[3]); }
    }
};
__device__ __forceinline__ bf16 f2bf_hw(float v) { return (bf16)(cvt_pk_bf16(v, v) & 0xffffu); }
__device__ __forceinline__ f32x4 mfma16(bf16x8 a, bf16x8 b, f32x4 c) { return __builtin_amdgcn_mfma_f32_16x16x32_bf16(a, b, c, 0, 0, 0); }
__device__ __forceinline__ u32x4 pack8(const float (&v)[8]) { u32x4 o; o.x = cvt_pk_bf16(v[0], v[1]); o.y = cvt_pk_bf16(v[2], v[3]); o.z = cvt_pk_bf16(v[4], v[5]); o.w = cvt_pk_bf16(v[6], v[7]); return o; }
__device__ __forceinline__ bf16x8 as_frag(u32x4 v) { return __builtin_bit_cast(bf16x8, v); }
constexpr size_t DO_XW = 0, DO_QD = 32 * MiB, DO_KE = 64 * MiB, DO_VT = 96 * MiB;
constexpr size_t WS_SSQM = WS_HID, WS_SCL = WS_HID + 8 * MiB;
constexpr int P_RAW = 0, P_SC = 0, P_XST = 36864, P_BS = 73728, P_CS = 91136, P_CUM = 108544, P_DTV = 110592, P_WT = 112640;
constexpr int H_RAW = 0, H_B0 = 49152, H_BLK = 40960, H_QD = 0, H_QS = 8704, H_KS = 17408, H_VT = 26112, H_SCH = 36352;

__device__ __forceinline__ void pre_issue(u32x4 (&pr)[6], const bf16* PROJ, bool hkind, int t0, int g, int hf, int hd, int tid) {
    asm volatile("" : "+v"(tid));
#pragma unroll
    for (int it = 0; it < 6; ++it) { const int idx = tid + 512 * it;
        const int idc = idx < 35 * 64 ? idx : 35 * 64 - 1, r = idc >> 6, j = idc & 63;
        const int col = j < 32 ? 512 + g * 256 + j * 8 : (j < 48 ? 1024 + g * 128 + (j - 32) * 8 : 1280 + g * 128 + (j - 48) * 8);
        int srow = t0 + hf * 32 - 3 + r; srow = srow < 0 ? 0 : srow;
        const unsigned offr = (unsigned)srow * PW + col;
        const int mt = idx >> 10, hr = (idx >> 4) & 63, hj = idx & 15;
        const unsigned offh = (unsigned)(t0 + hr) * PW + 1536 + mt * 512 + hd * 128 + hj * 8;
        pr[it] = *(const u32x4*)(PROJ + (hkind ? offh : offr)); }
}
__device__ __forceinline__ void raw_commit(const u32x4 (&pr)[6], LAS bf16* RAW, int tid, int c, int hf) {
    asm volatile("" : "+v"(tid));
#pragma unroll
    for (int it = 0; it < 5; ++it) { const int idx = tid + 512 * it;
        if (idx < 35 * 64) { const bool z = (c == 0) && (hf * 32 - 3 + (idx >> 6) < 0);
            *(LAS u32x4*)(RAW + (idx >> 6) * 512 + (idx & 63) * 8) = z ? (u32x4){0u, 0u, 0u, 0u} : pr[it]; } }
}
__device__ __forceinline__ void hraw_commit(const u32x4 (&pr)[6], LAS bf16* HRAW, int tid) {
    asm volatile("" : "+v"(tid));
#pragma unroll
    for (int it = 0; it < 6; ++it) { const int idx = tid + 512 * it, mt = idx >> 10, r = (idx >> 4) & 63, j = idx & 15; *(LAS u32x4*)(HRAW + mt * 8192 + r * 128 + j * 8) = pr[it]; }
}

#define LBAR() do { asm volatile("s_waitcnt lgkmcnt(0)" ::: "memory"); __builtin_amdgcn_s_barrier(); asm volatile("" ::: "memory"); } while (0)
__device__ __forceinline__ void pre_phase(const Args& args, int l, LAS unsigned char* lds, int G, int mode = 7) {
    int tid = threadIdx.x; asm volatile("" : "+v"(tid));
    GAS unsigned char* wsg_ = (GAS unsigned char*)args.ws; asm volatile("" : "+s"(wsg_)); unsigned char* ws = (unsigned char*)wsg_;
    const int lane = tid & 63, wave = __builtin_amdgcn_readfirstlane(tid >> 6), q = lane >> 4, l15 = lane & 15;
    const bf16* XB = (const bf16*)(ws + WS_XB); const bf16* PROJ = (const bf16*)(ws + WS_PROJ); const bf16* WDT = (const bf16*)(ws + WS_WDT) + (size_t)l * 16 * D;
    const float* SSQ = (const float*)(ws + WS_SSQ); float* E1 = (float*)(ws + WS_E1); float* BLKDEC = (float*)(ws + WS_BLKDEC);
    bf16* YA = (bf16*)(ws + WS_YA); unsigned char* BCT = ws + WS_BCT; unsigned char* CCF = ws + WS_CC;
    unsigned char* dout = (unsigned char*)args.out; unsigned char* XWF = dout + DO_XW; unsigned char* QDF = dout + DO_QD; unsigned char* KEF = dout + DO_KE; unsigned char* VTF = dout + DO_VT;
    const float* conv_w = args.in[3] + l * 4096; const float* conv_b = args.in[4] + l * 1024; const float* dt_bias = args.in[5] + l * 8;
    const float* a_log = args.in[6] + l * 8; const float* d_skip = args.in[7] + l * 8; const float* lbl = args.in[9];
    LAS float* CUM = (LAS float*)(lds + P_CUM); LAS float* DTV = (LAS float*)(lds + P_DTV);
    LAS bf16* XST = (LAS bf16*)(lds + P_XST); LAS bf16* BS = (LAS bf16*)(lds + P_BS); LAS bf16* CS = (LAS bf16*)(lds + P_CS); LAS bf16* SC = (LAS bf16*)(lds + P_SC);
    u32x4 pr[6];
    float cwa[5], cwb[5];
    {   const int role = tid < 256 ? 0 : (tid < 384 ? 1 : 2);
        const int c0 = role == 0 ? tid : (role == 1 ? 512 + (tid - 256) : 768 + (tid - 384)), c1 = role == 0 ? 256 + tid : (role == 1 ? 512 + 128 + (tid - 256) : 768 + 128 + (tid - 384));
#pragma unroll
        for (int i = 0; i < 4; ++i) { cwa[i] = conv_w[i * 1024 + c0]; cwb[i] = conv_w[i * 1024 + c1]; }
        cwa[4] = conv_b[c0]; cwb[4] = conv_b[c1]; }
    float dska[4], dskb[4];
#pragma unroll
    for (int i = 0; i < 4; ++i) { dska[i] = d_skip[i]; dskb[i] = d_skip[4 + i]; }
    float lbh[4];
#pragma unroll
    for (int i = 0; i < 4; ++i) lbh[i] = (l == 1) ? rcpf(1.f + __expf(lbl[i * 128 + (tid & 127)] - lbl[512 + i * 128 + (tid & 127)])) : 0.f;
    const float dtb = dt_bias[wave], nega = -__expf(a_log[wave]);
    float nraw; f32x4 nssq;
    { const int u0 = (int)blockIdx.x < NB * 128 ? (int)blockIdx.x : NB * 128 - 1, ft0 = (u0 >> 7) * SEQ + (u0 & 127) * 64;
      nraw = ((const float*)(ws + WS_DT))[(size_t)(ft0 + lane) * 8 + wave]; nssq = *(const f32x4*)(SSQ + (size_t)(ft0 + lane) * 4);
      pre_issue(pr, PROJ, false, ft0, 0, 0, 0, tid); }
    for (int unit = blockIdx.x; unit < NB * 128; unit += G) {
        const int b = unit >> 7, c = unit & 127, t0 = b * SEQ + c * 64;
        if (mode & 4) {
        {   const int hh = wave, t = lane;
            const float raw = nraw;
            const float rs = rsqrtf(((nssq[0] + nssq[1]) + (nssq[2] + nssq[3])) * (1.f / D) + EPS);
            const float dtv = softplusf(raw * rs + dtb); float v = dtv * nega;
#pragma unroll
            for (int o = 1; o < 64; o <<= 1) { const float n = __shfl_up(v, o); if (lane >= o) v += n; }
            CUM[t * 8 + hh] = v; DTV[t * 8 + hh] = dtv; E1[((size_t)(t0 >> 6) * 2 + (hh >> 2)) * 256 + t * 4 + (hh & 3)] = __expf(v);
            ((LAS float*)(lds + P_WT))[t * 8 + hh] = __expf(__shfl(v, 63) - v) * dtv;
        }
        LBAR();
        }
        if (mode & 1)
        for (int g = 0; g < 2; ++g) {
            {
                const int role = tid < 256 ? 0 : (tid < 384 ? 1 : 2);
                const int cch = role == 0 ? g * 256 + tid : (role == 1 ? 512 + g * 128 + (tid - 256) : 768 + g * 128 + (tid - 384));
                const float w0 = g ? cwb[0] : cwa[0], w1 = g ? cwb[1] : cwa[1], w2 = g ? cwb[2] : cwa[2], w3 = g ? cwb[3] : cwa[3], cbias = g ? cwb[4] : cwa[4];
                const int h = (g * 256 + tid) >> 6;
                const LAS float* WTB = (const LAS float*)(lds + P_WT);
                LAS bf16* RAW = (LAS bf16*)(lds + P_RAW);
                for (int hf = 0; hf < 2; ++hf) {
                    raw_commit(pr, RAW, tid, c, hf);
                    pre_issue(pr, PROJ, hf == 1 && g == 1, t0, hf == 0 ? g : 1, hf == 0 ? 1 : 0, 0, tid);
                    LBAR();
                    float u0 = bf2f(RAW[tid]), u1 = bf2f(RAW[512 + tid]), u2 = bf2f(RAW[1024 + tid]);
#pragma unroll
                    for (int sq = 0; sq < 4; ++sq) {
                        const int sg = hf * 4 + sq;
                        float v[8];
#pragma unroll
                        for (int jj = 0; jj < 8; ++jj) { const float u3 = bf2f(RAW[(3 + sq * 8 + jj) * 512 + tid]);
                            const float x = cbias + w0 * u0 + w1 * u1 + w2 * u2 + w3 * u3; v[jj] = siluf(x); u0 = u1; u1 = u2; u2 = u3; }
                        u32x4 gsv = pack8(v); unsigned char* gsa = ws + WS_SCL + ((size_t)blockIdx.x * 512 + tid) * 16;
                        if (role == 0) {
                            *(LAS u32x4*)(XST + tid * 72 + sg * 8) = gsv;
                            float xw[8];
#pragma unroll
                            for (int jj = 0; jj < 8; ++jj) { const int s = sg * 8 + jj; xw[jj] = v[jj] * WTB[s * 8 + h]; }
                            const int ch = g * 256 + tid, ps = (ch & 63) >> 4;
                            gsa = XWF + (((((size_t)(b * 128 + c) * 8 + h) * 4 + ps) * 2 + (sg >> 2)) * 1024) + ((sg & 3) * 16 + (ch & 15)) * 16; gsv = pack8(xw);
                        } else if (role == 1) {
                            const int n = tid - 256;
#pragma unroll
                            for (int jj = 0; jj < 8; ++jj) BS[(sg * 8 + jj) * 136 + n] = f2bf_hw(v[jj]);
                            gsa = BCT + ((((size_t)(b * 128 + c) * 2 + g) * 16 + (n >> 4) * 2 + (sg >> 2)) * 1024) + ((sg & 3) * 16 + (n & 15)) * 16;
                        } else {
                            const int n = tid - 384;
#pragma unroll
                            for (int jj = 0; jj < 8; ++jj) CS[(sg * 8 + jj) * 136 + n] = f2bf_hw(v[jj]);
                        }
                        *(u32x4*)gsa = gsv;
                    }
                    LBAR();
                }
            }
#pragma unroll
            for (int ff = 0; ff < 2; ++ff) { const int f = wave * 2 + ff, tt = f >> 2, i = f & 3;
                const LAS bf16* row = CS + (16 * tt + l15) * 136 + 32 * i + 4 * q;
                const u32x2 lo = *(const LAS u32x2*)row, hi = *(const LAS u32x2*)(row + 16);
                *(u32x4*)(CCF + ((((size_t)(b * 128 + c) * 2 + g) * 16 + f) * 1024) + lane * 16) = (u32x4){lo.x, lo.y, hi.x, hi.y}; }
#pragma unroll
            for (int k2 = 0; k2 < 2; ++k2) { const int idx = wave * 2 + k2, ti = idx >> 2, si = idx & 3;
                f32x4 cb = (f32x4){0.f, 0.f, 0.f, 0.f};
                if (si <= ti) {
#pragma unroll
                    for (int i = 0; i < 4; ++i) cb = mfma16(*(const LAS bf16x8*)(CS + (16 * ti + l15) * 136 + 32 * i + 8 * q), *(const LAS bf16x8*)(BS + (16 * si + l15) * 136 + 32 * i + 8 * q), cb); }
                const int s = 16 * si + l15;
#pragma unroll
                for (int hh = 0; hh < 4; ++hh) { const int h = g * 4 + hh; const float cs = CUM[s * 8 + h], dts = DTV[s * 8 + h], dsk = g ? dskb[hh] : dska[hh];
#pragma unroll
                    for (int r = 0; r < 4; ++r) { const int t = 16 * ti + 4 * q + r; float val = (s <= t) ? cb[r] * __expf(CUM[t * 8 + h] - cs) * dts : 0.f; if (s == t) val += dsk;
                        SC[(hh * 64 + t) * 72 + s] = f2bf_hw(val); } }
            }
            LBAR();
#pragma unroll
            for (int k8 = 0; k8 < 8; ++k8) { const int idx = wave * 8 + k8, hh = idx >> 4, pi = (idx >> 2) & 3, ti = idx & 3;
                f32x4 acc = (f32x4){0.f, 0.f, 0.f, 0.f};
#pragma unroll
                for (int i2 = 0; i2 < 2; ++i2) if (i2 == 0 || ti >= 2)
                    acc = mfma16(*(const LAS bf16x8*)(XST + (hh * 64 + 16 * pi + l15) * 72 + 32 * i2 + 8 * q), *(const LAS bf16x8*)(SC + (hh * 64 + 16 * ti + l15) * 72 + 32 * i2 + 8 * q), acc);
                u32x2 w; w.x = cvt_pk_bf16(acc[0], acc[1]); w.y = cvt_pk_bf16(acc[2], acc[3]);
                *(u32x2*)(YA + perm_idx(t0 + 16 * ti + l15, (g * 4 + hh) * 64 + 16 * pi + 4 * q, 1024)) = w; }
            LBAR();
        }
        if (mode & 2)
        for (int hd = 0; hd < 4; ++hd) {
            {
                hraw_commit(pr, (LAS bf16*)(lds + H_RAW), tid);
                {   const int nu = unit + G < NB * 128 ? unit + G : unit;
                    const int nt0 = (nu >> 7) * SEQ + (nu & 127) * 64;
                    pre_issue(pr, PROJ, hd < 3, hd < 3 ? t0 : nt0, 0, 0, hd + 1, tid);
                    nraw = ((const float*)(ws + WS_DT))[(size_t)(nt0 + lane) * 8 + wave]; nssq = *(const f32x4*)(SSQ + (size_t)(nt0 + lane) * 4); }
            }
            LBAR();
            {
                const int bb = tid >> 8, hf = (tid >> 7) & 1, k = tid & 127, ch = hd * 128 + k, blk = c * 2 + bb;
                const float lb = hd == 0 ? lbh[0] : (hd == 1 ? lbh[1] : (hd == 2 ? lbh[2] : lbh[3]));
                const LAS bf16* pq = (const LAS bf16*)(lds + H_RAW) + (bb * 32 + hf * 16) * 128 + k; const LAS bf16* pf = pq + 8192; const LAS bf16* pi_ = pq + 16384;
                LAS unsigned char* hb = lds + H_B0 + bb * H_BLK;
                LAS bf16* QD = (LAS bf16*)(hb + H_QD); LAS bf16* QS = (LAS bf16*)(hb + H_QS); LAS bf16* KS = (LAS bf16*)(hb + H_KS); LAS bf16* VT = (LAS bf16*)(hb + H_VT);
                LAS float* EX = (LAS float*)(hb + 38912);
                float bc[16], omf[16]; float run = 0.f;
#pragma unroll
                for (int i = 0; i < 16; ++i) { const float f = lb + (1.f - lb) * sigmf(bf2f(pf[i * 128])); run += __logf(f); bc[i] = run; omf[i] = 1.f - f; }
                EX[hf * 128 + k] = run; if (hf) EX[256 + k] = bc[0];
                LBAR();
                const float tot0 = EX[k], tot1 = EX[128 + k], b16 = tot0 + EX[256 + k], E16 = __expf(b16), E31 = __expf(tot0 + tot1 - b16);
                const float off = hf ? tot0 : 0.f;
                const size_t fb = ((((size_t)(b * 256 + blk) * 4 + hd) * 8 + (k >> 4)) * 1024);
#pragma unroll
                for (int sq = 0; sq < 2; ++sq) { const int sg = hf * 2 + sq;
                    float ke[8], vv[8];
#pragma unroll
                    for (int jj = 0; jj < 8; ++jj) { const int i = sq * 8 + jj, t = hf * 16 + i; const float bt = bc[i] + off, bp = (i ? bc[i ? i - 1 : 0] : 0.f) + off;
                        const float eb = __expf(bt - b16), ieb = rcpf(eb), omt = omf[i];
                        const float qv = bf2f(pq[i * 128]);
                        QD[t * 136 + k] = f2bf_hw(qv * eb * E16); QS[t * 136 + k] = f2bf_hw(qv * eb); KS[t * 136 + k] = f2bf_hw(omt * ieb);
                        ke[jj] = omt * ieb * E31; vv[jj] = bf2f(pi_[i * 128]); }
                    const u32x4 vp = pack8(vv);
                    *(u32x4*)(KEF + fb + (sg * 16 + (k & 15)) * 16) = pack8(ke);
                    *(u32x4*)(VTF + fb + (sg * 16 + (k & 15)) * 16) = vp;
                    *(LAS u32x4*)(VT + k * 40 + sg * 8) = vp;
                }
                if (hf == 0) BLKDEC[(size_t)(b * 256 + blk) * 512 + ch] = E16 * E31;
            }
            LBAR();
            {
                const int bb = wave >> 2, ti = (wave >> 1) & 1, si = wave & 1; LAS unsigned char* hb = lds + H_B0 + bb * H_BLK;
                const LAS bf16* QS = (const LAS bf16*)(hb + H_QS); const LAS bf16* KS = (const LAS bf16*)(hb + H_KS); LAS bf16* SCH = (LAS bf16*)(hb + H_SCH);
                f32x4 sc = (f32x4){0.f, 0.f, 0.f, 0.f};
                if (si <= ti) {
#pragma unroll
                    for (int i = 0; i < 4; ++i) sc = mfma16(*(const LAS bf16x8*)(QS + (16 * ti + l15) * 136 + 32 * i + 8 * q), *(const LAS bf16x8*)(KS + (16 * si + l15) * 136 + 32 * i + 8 * q), sc); }
                const int s = 16 * si + l15;
#pragma unroll
                for (int r = 0; r < 4; ++r) { const int t = 16 * ti + 4 * q + r; SCH[t * 40 + s] = f2bf_hw(s <= t ? sc[r] : 0.f); }
            }
#pragma unroll
            for (int ff = 0; ff < 2; ++ff) { const int f = wave * 2 + ff, bb = f >> 3, tt = (f >> 2) & 1, i = f & 3;
                const LAS bf16* row = (const LAS bf16*)(lds + H_B0 + bb * H_BLK + H_QD) + (16 * tt + l15) * 136 + 32 * i + 4 * q;
                const u32x2 lo = *(const LAS u32x2*)row, hi = *(const LAS u32x2*)(row + 16);
                *(u32x4*)(QDF + ((((size_t)(b * 256 + c * 2 + bb) * 4 + hd) * 8 + tt * 4 + i) * 1024) + lane * 16) = (u32x4){lo.x, lo.y, hi.x, hi.y}; }
            LBAR();
#pragma unroll
            for (int k4 = 0; k4 < 4; ++k4) { const int idx = wave * 4 + k4, bb = idx >> 4, vi = (idx >> 1) & 7, ti = idx & 1; LAS unsigned char* hb = lds + H_B0 + bb * H_BLK;
                const f32x4 acc = mfma16(*(const LAS bf16x8*)((const LAS bf16*)(hb + H_VT) + (16 * vi + l15) * 40 + 8 * q), *(const LAS bf16x8*)((const LAS bf16*)(hb + H_SCH) + (16 * ti + l15) * 40 + 8 * q), (f32x4){0.f, 0.f, 0.f, 0.f});
                u32x2 w; w.x = cvt_pk_bf16(acc[0], acc[1]); w.y = cvt_pk_bf16(acc[2], acc[3]);
                *(u32x2*)(YA + perm_idx(t0 + bb * 32 + 16 * ti + l15, 512 + hd * 128 + 16 * vi + 4 * q, 1024)) = w; }
            LBAR();
        }
    }
}

constexpr int SQ_SLOT = 43008, SQ_R = 3, SQ_NP = 39;
constexpr int SQ_EX = 135936;
__device__ __forceinline__ void seq_issue(const unsigned char* const (&pb)[7], const int (&stride)[7], const int (&dstp)[7], int cidx, LAS unsigned char* slot) {
#pragma unroll
    for (int k = 0; k < 7; ++k)
        __builtin_amdgcn_global_load_lds((const unsigned*)(pb[k] + (size_t)cidx * stride[k]), (LAS unsigned*)(slot + dstp[k] * 1024), 16, 0, 0);
}
__device__ __forceinline__ void seq_phase(const Args& args, LAS unsigned char* lds, int G, int vb, bool dry = false, bool nocompute = false, int xm = 0) {
    int tid = threadIdx.x; asm volatile("" : "+v"(tid));
    GAS unsigned char* wsg_ = (GAS unsigned char*)args.ws; asm volatile("" : "+s"(wsg_)); unsigned char* ws = (unsigned char*)wsg_;
    const int lane = tid & 63, wave = __builtin_amdgcn_readfirstlane(tid >> 6), q = lane >> 4, l15 = lane & 15;
    unsigned char* dout = (unsigned char*)args.out;
    bf16* YA = (bf16*)(ws + WS_YA); float* SSQM = (float*)(ws + WS_SSQM);
    for (int task = vb; task < 256; task += G) {
        const int xc = task & 7, si = task >> 3;
        const bool ssd = si < 16;
        int b = xc >> 1, hh, sl;
        if (ssd) { hh = (xc & 1) * 4 + (si >> 2); sl = si & 3; } else { hh = (xc & 1) * 2 + ((si - 16) >> 3); sl = si & 7; }
        const int ycol = ssd ? hh * 64 + sl * 16 : 512 + hh * 128 + sl * 16;
        const int gcol = ssd ? hh * 64 + sl * 16 : 3072 + hh * 128 + sl * 16;
        __syncthreads();
        if (wave >= 2) {
            int ln = lane; asm volatile("" : "+v"(ln));
            const unsigned char* pb[7]; int stride[7]; int dstp[7];
#pragma unroll
            for (int k = 0; k < 7; ++k) {
                int p = (wave - 2) + 6 * k; dstp[k] = p; if (p >= SQ_NP) p -= 6;
            const unsigned char* base; int st;
            if (ssd) {
                const int g = hh >> 2;
                if (p < 16)      { base = ws + WS_CC  + (((size_t)(b * 128) * 2 + g) * 16 + p) * 1024 + ln * 16; st = 2 * 16 * 1024; }
                else if (p < 32) { base = ws + WS_BCT + (((size_t)(b * 128) * 2 + g) * 16 + (p - 16)) * 1024 + ln * 16; st = 2 * 16 * 1024; }
                else if (p < 34) { base = dout + DO_XW + ((((size_t)(b * 128) * 8 + hh) * 4 + sl) * 2 + (p - 32)) * 1024 + ln * 16; st = 8 * 4 * 2 * 1024; }
                else if (p < 36) { base = ws + WS_YA + perm_idx(b * SEQ + ln, ycol + 8 * (p - 34), 1024) * 2; st = 64 * 1024 * 2; }
                else if (p < 38) { base = ws + WS_PROJ + perm_idx(b * SEQ + ln, gcol + 8 * (p - 36), PW) * 2; st = 64 * PW * 2; }
                else             { base = ws + WS_E1 + (((size_t)(b * 128) * 2 + (hh >> 2)) * 256 + ln * 4) * 4; st = 2 * 256 * 4; }
            } else {
                if (p < 16)      { base = dout + DO_QD + ((((size_t)(b * 256) + (p >> 3)) * 4 + hh) * 8 + (p & 7)) * 1024 + ln * 16; st = 2 * 4 * 8 * 1024; }
                else if (p < 32) { base = dout + DO_KE + ((((size_t)(b * 256) + ((p - 16) >> 3)) * 4 + hh) * 8 + ((p - 16) & 7)) * 1024 + ln * 16; st = 2 * 4 * 8 * 1024; }
                else if (p < 34) { base = dout + DO_VT + ((((size_t)(b * 256) + (p - 32)) * 4 + hh) * 8 + sl) * 1024 + ln * 16; st = 2 * 4 * 8 * 1024; }
                else if (p < 36) { base = ws + WS_YA + perm_idx(b * SEQ + ln, ycol + 8 * (p - 34), 1024) * 2; st = 64 * 1024 * 2; }
                else if (p < 38) { base = ws + WS_PROJ + perm_idx(b * SEQ + ln, gcol + 8 * (p - 36), PW) * 2; st = 64 * PW * 2; }
                else             { base = ws + WS_BLKDEC + ((size_t)(b * 256 + (ln >> 5)) * 512 + hh * 128 + 4 * (ln & 31)) * 4; st = 2 * 512 * 4; }
            }
            if (xm == 1 && p >= 34) { base = ws + WS_CC + (((size_t)(b * 128) * 2 + (hh >> 2 & 1)) * 16 + (p - 34)) * 1024 + ln * 16; st = 2 * 16 * 1024; }
            if (xm == 2 && p < 34) { base = ws + WS_YA + ((size_t)(b * SEQ + ln) * 1024 + ycol + 8 * (p & 1)) * 2; st = 64 * 1024 * 2; }
            pb[k] = base; stride[k] = st;
            }
            seq_issue(pb, stride, dstp, 0, lds);
            seq_issue(pb, stride, dstp, 1, lds + SQ_SLOT);
            for (int c = 0; c < 128; ++c) {
                if (c < 127) asm volatile("s_waitcnt vmcnt(7)" ::: "memory"); else asm volatile("s_waitcnt vmcnt(0)" ::: "memory");
                __builtin_amdgcn_s_barrier(); asm volatile("" ::: "memory");
                if (c + 2 < 128) seq_issue(pb, stride, dstp, c + 2, lds + ((c + 2) % SQ_R) * SQ_SLOT);
                if (!nocompute) { __builtin_amdgcn_s_barrier(); if (!ssd) __builtin_amdgcn_s_barrier(); }
            }
        } else {
            const int h = wave;
            f32x4 X[4];
#pragma unroll
            for (int j = 0; j < 4; ++j) X[j] = (f32x4){0.f, 0.f, 0.f, 0.f};
            for (int c = 0; c < 128; ++c) {
                __builtin_amdgcn_s_barrier(); asm volatile("" ::: "memory");
                if (nocompute) continue;
                const LAS unsigned char* L = lds + (c % SQ_R) * SQ_SLOT;
                const int t0 = b * SEQ + c * 64;
                if (ssd) {
                    LAS unsigned char* exw = lds + SQ_EX + h * 2048; const LAS unsigned char* exr = lds + SQ_EX + (1 - h) * 2048;
                    bf16x8 F[8], Gf[8];
#pragma unroll
                    for (int tt = 0; tt < 4; ++tt)
#pragma unroll
                        for (int ii = 0; ii < 2; ++ii) F[tt * 2 + ii] = *(const LAS bf16x8*)(L + (tt * 4 + 2 * h + ii) * 1024 + lane * 16);
                    u32x2 ya[2], zz[2]; float e1[2];
#pragma unroll
                    for (int k = 0; k < 2; ++k) { const int t = 16 * (2 * h + k) + l15;
                        e1[k] = *(const LAS float*)(L + 38 * 1024 + t * 16 + (hh & 3) * 4);
                        ya[k] = *(const LAS u32x2*)(L + (34 + (q >> 1)) * 1024 + t * 16 + (q & 1) * 8);
                        zz[k] = *(const LAS u32x2*)(L + (36 + (q >> 1)) * 1024 + t * 16 + (q & 1) * 8); }
                    const float cdec = *(const LAS float*)(L + 38 * 1024 + 63 * 16 + (hh & 3) * 4);
#pragma unroll
                    for (int p = 0; p < 8; ++p) Gf[p] = *(const LAS bf16x8*)(L + (16 + 8 * h + p) * 1024 + lane * 16);
                    const bf16x8 xw0 = *(const LAS bf16x8*)(L + 32 * 1024 + lane * 16), xw1 = *(const LAS bf16x8*)(L + 33 * 1024 + lane * 16);
                    bf16x8 af[2];
#pragma unroll
                    for (int i = 0; i < 2; ++i) { u32x4 w; w.x = cvt_pk_bf16(X[2 * i][0], X[2 * i][1]); w.y = cvt_pk_bf16(X[2 * i][2], X[2 * i][3]);
                        w.z = cvt_pk_bf16(X[2 * i + 1][0], X[2 * i + 1][1]); w.w = cvt_pk_bf16(X[2 * i + 1][2], X[2 * i + 1][3]); af[i] = as_frag(w); }
                    __builtin_amdgcn_sched_barrier(0);
                    f32x4 yi[4];
#pragma unroll
                    for (int tt = 0; tt < 4; ++tt) yi[tt] = mfma16(af[0], F[tt * 2], (f32x4){0.f, 0.f, 0.f, 0.f});
#pragma unroll
                    for (int tt = 0; tt < 4; ++tt) yi[tt] = mfma16(af[1], F[tt * 2 + 1], yi[tt]);
#pragma unroll
                    for (int k = 0; k < 2; ++k) *(LAS f32x4*)(exw + k * 1024 + lane * 16) = h ? yi[k] : yi[2 + k];
#pragma unroll
                    for (int j = 0; j < 4; ++j) X[j] = mfma16(Gf[j * 2], xw0, X[j] * cdec);
#pragma unroll
                    for (int j = 0; j < 4; ++j) X[j] = mfma16(Gf[j * 2 + 1], xw1, X[j]);
                    asm volatile("s_waitcnt lgkmcnt(0)" ::: "memory"); __builtin_amdgcn_s_barrier(); asm volatile("" ::: "memory");
#pragma unroll
                    for (int k = 0; k < 2; ++k) { const int tt = 2 * h + k, t = 16 * tt + l15;
                        const f32x4 yo = (h ? yi[2 + k] : yi[k]) + *(const LAS f32x4*)(exr + k * 1024 + lane * 16);
                        const float yv[4] = {bflo(ya[k].x), bfhi(ya[k].x), bflo(ya[k].y), bfhi(ya[k].y)}; const float zv[4] = {bflo(zz[k].x), bfhi(zz[k].x), bflo(zz[k].y), bfhi(zz[k].y)};
                        float o[4], s = 0.f;
#pragma unroll
                        for (int r = 0; r < 4; ++r) { o[r] = (yv[r] + e1[k] * yo[r]) * siluf(zv[r]); s += o[r] * o[r]; }
                        u32x2 w; w.x = cvt_pk_bf16(o[0], o[1]); w.y = cvt_pk_bf16(o[2], o[3]);
                        if (!dry) *(u32x2*)(YA + perm_idx(t0 + t, ycol + 4 * q, 1024)) = w; else asm volatile("" :: "v"(w.x), "v"(w.y));
                        s += __shfl_xor(s, 16); s += __shfl_xor(s, 32);
                        if (q == 0 && !dry) SSQM[(size_t)(t0 + t) * 64 + hh * 4 + sl] = s; }
                } else {
#pragma unroll
                    for (int bb = 0; bb < 2; ++bb) {
                        LAS unsigned char* exw = lds + SQ_EX + (bb * 2 + h) * 1024; const LAS unsigned char* exr = lds + SQ_EX + (bb * 2 + 1 - h) * 1024;
                        bf16x8 F[4], Gf[4]; f32x4 dec[4];
#pragma unroll
                        for (int tt = 0; tt < 2; ++tt)
#pragma unroll
                            for (int ii = 0; ii < 2; ++ii) F[tt * 2 + ii] = *(const LAS bf16x8*)(L + (bb * 8 + tt * 4 + 2 * h + ii) * 1024 + lane * 16);
                        const int t = bb * 32 + 16 * h + l15;
                        const u32x2 ya = *(const LAS u32x2*)(L + (34 + (q >> 1)) * 1024 + t * 16 + (q & 1) * 8), zz = *(const LAS u32x2*)(L + (36 + (q >> 1)) * 1024 + t * 16 + (q & 1) * 8);
#pragma unroll
                        for (int p = 0; p < 4; ++p) { Gf[p] = *(const LAS bf16x8*)(L + (16 + bb * 8 + 4 * h + p) * 1024 + lane * 16); dec[p] = *(const LAS f32x4*)(L + 38 * 1024 + (bb * 32 + 4 * (4 * h + p) + q) * 16); }
                        const bf16x8 vt = *(const LAS bf16x8*)(L + (32 + bb) * 1024 + lane * 16);
                        bf16x8 af[2];
#pragma unroll
                        for (int i = 0; i < 2; ++i) { u32x4 w; w.x = cvt_pk_bf16(X[2 * i][0], X[2 * i][1]); w.y = cvt_pk_bf16(X[2 * i][2], X[2 * i][3]);
                            w.z = cvt_pk_bf16(X[2 * i + 1][0], X[2 * i + 1][1]); w.w = cvt_pk_bf16(X[2 * i + 1][2], X[2 * i + 1][3]); af[i] = as_frag(w); }
                        __builtin_amdgcn_sched_barrier(0);
                        f32x4 oi[2];
#pragma unroll
                        for (int tt = 0; tt < 2; ++tt) oi[tt] = mfma16(af[0], F[tt * 2], (f32x4){0.f, 0.f, 0.f, 0.f});
#pragma unroll
                        for (int tt = 0; tt < 2; ++tt) oi[tt] = mfma16(af[1], F[tt * 2 + 1], oi[tt]);
                        *(LAS f32x4*)(exw + lane * 16) = h ? oi[0] : oi[1];
#pragma unroll
                        for (int j = 0; j < 4; ++j) X[j] = mfma16(Gf[j], vt, X[j] * dec[j]);
                        asm volatile("s_waitcnt lgkmcnt(0)" ::: "memory"); __builtin_amdgcn_s_barrier(); asm volatile("" ::: "memory");
                        {   const f32x4 ot = (h ? oi[1] : oi[0]) + *(const LAS f32x4*)(exr + lane * 16);
                            const float yv[4] = {bflo(ya.x), bfhi(ya.x), bflo(ya.y), bfhi(ya.y)}; const float zv[4] = {bflo(zz.x), bfhi(zz.x), bflo(zz.y), bfhi(zz.y)};
                            float o[4], s = 0.f;
#pragma unroll
                            for (int r = 0; r < 4; ++r) { const float ov = yv[r] + ot[r]; s += ov * ov; o[r] = ov * siluf(zv[r]); }
                            u32x2 w; w.x = cvt_pk_bf16(o[0], o[1]); w.y = cvt_pk_bf16(o[2], o[3]);
                            if (!dry) *(u32x2*)(YA + perm_idx(t0 + t, ycol + 4 * q, 1024)) = w; else asm volatile("" :: "v"(w.x), "v"(w.y));
                            s += __shfl_xor(s, 16); s += __shfl_xor(s, 32);
                            if (q == 0 && !dry) SSQM[(size_t)(t0 + t) * 64 + 32 + hh * 8 + sl] = s; }
                    }
                }
            }
        }
        __syncthreads();
    }
}

__device__ __forceinline__ void norm_phase(const Args& args, int l, int G) {
    int tid = threadIdx.x; asm volatile("" : "+v"(tid));
    GAS unsigned char* wsg_ = (GAS unsigned char*)args.ws; asm volatile("" : "+s"(wsg_)); unsigned char* ws = (unsigned char*)wsg_;
    const int lane = tid & 63, wave = __builtin_amdgcn_readfirstlane(tid >> 6);
    const float* SSQM = (const float*)(ws + WS_SSQM); float* SCL = (float*)(ws + WS_SCL);
    for (int t0 = blockIdx.x * NWAVES + wave; t0 < T; t0 += 4 * G * NWAVES) {
        float pp[4];
#pragma unroll
        for (int r = 0; r < 4; ++r) { const int t = t0 + r * G * NWAVES; pp[r] = SSQM[(size_t)(t < T ? t : t0) * 64 + lane]; }
#pragma unroll
        for (int r = 0; r < 4; ++r) { const int t = t0 + r * G * NWAVES; float p = pp[r];
        p += __shfl_xor(p, 1); p += __shfl_xor(p, 2); p += __shfl_xor(p, 4);
        const float p8 = p; p += __shfl_xor(p, 8);
        const float sumS = __shfl(p, (lane & 1) * 16), sumH = __shfl(p8, 32 + ((lane - 2) & 3) * 8);
        const float sc = lane < 2 ? rsqrtf(sumS * (1.f / 256.f) + EPS) : rsqrtf(sumH * (1.f / 128.f) + EPS);
        const float nx = __shfl(sc, (lane + 1) & 63);
        const float o = lane < 5 ? sc * rcpf(nx) : (lane == 5 ? sc : 0.f);
        if (lane < 8 && t < T) SCL[(size_t)t * 8 + lane] = o; }
    }
}
#define XB_TMO      128
#define XB_XCNT(j)  (256  + 64 * (j))
#define XB_XSUB(j)  (1280 + 64 * (j))
#define XB_XGEN(j)  (2304 + 64 * (j))
#define XB_TOP      3328
#define XB_TOPGEN   3392
#define XCD_BAR_WORDS 3456
#define XB_SPIN_CAP (1u << 24)
__device__ __forceinline__ unsigned xb_ld(unsigned* p)              { return __hip_atomic_load(p, __ATOMIC_RELAXED, __HIP_MEMORY_SCOPE_AGENT); }
__device__ __forceinline__ unsigned xb_add(unsigned* p, unsigned v) { return __hip_atomic_fetch_add(p, v, __ATOMIC_RELAXED, __HIP_MEMORY_SCOPE_AGENT); }
__device__ __forceinline__ unsigned xb_xcc_id() { return (unsigned)__builtin_amdgcn_s_getreg((3 << 11) | 20) & 0xFu; }
#define XB_SPIN(cond, bar) do { unsigned _sp = 0; while (cond) { __builtin_amdgcn_s_sleep(1); \
    if ((++_sp & 255u) == 0u) { if (xb_ld(&(bar)[XB_TMO])) break; if (_sp > XB_SPIN_CAP) { atomicAdd(&(bar)[XB_TMO], 1u); break; } } } } while (0)
struct XcdBarrier { unsigned* bar; unsigned x; volatile LAS unsigned* st; };
__device__ __forceinline__ XcdBarrier xcd_barrier_post(unsigned* bar, volatile LAS unsigned* st) {
    XcdBarrier b; b.bar = bar; b.x = xb_xcc_id(); b.st = st;
    if (threadIdx.x == 0) st[2] = xb_add(&bar[XB_XCNT(b.x)], 1u);
    return b;
}
__device__ __forceinline__ void xcd_barrier_complete(unsigned* bar, unsigned x, unsigned& nloc, unsigned& nx) {
    const unsigned G = gridDim.x * gridDim.y * gridDim.z;
    unsigned sum, cnt, mine, sp = 0u;
    for (;;) {
        sum = 0u; cnt = 0u; mine = 0u;
#pragma unroll
        for (unsigned j = 0; j < 16; ++j) { const unsigned c = xb_ld(&bar[XB_XCNT(j)]); sum += c; cnt += (c > 0u) ? 1u : 0u; mine = (j == x) ? c : mine; }
        if (sum == G) break;
        __builtin_amdgcn_s_sleep(1);
        if ((++sp & 255u) == 0u) { if (xb_ld(&bar[XB_TMO])) break; if (sp > XB_SPIN_CAP) { atomicAdd(&bar[XB_TMO], 1u); break; } }
    }
    nloc = mine > 0u ? mine : 1u; nx = cnt > 0u ? cnt : 1u;
}
__device__ __forceinline__ void xcd_barrier(const XcdBarrier& b) {
    asm volatile("s_waitcnt vmcnt(0)" ::: "memory");
    __syncthreads();
    if (threadIdx.x == 0) {
        unsigned* bar = b.bar;
        __builtin_amdgcn_s_waitcnt(0);
        unsigned nloc = b.st[0], nx = b.st[1];
        if (nloc == 0u) { xcd_barrier_complete(bar, b.x, nloc, nx); b.st[0] = nloc; b.st[1] = nx; }
        const unsigned old = xb_add(&bar[XB_XSUB(b.x)], 1u);
        const unsigned gen = old / nloc;
        if (old + 1u == (gen + 1u) * nloc) {
            __builtin_amdgcn_fence(__ATOMIC_RELEASE, "agent");
            asm volatile("s_waitcnt vmcnt(0)" ::: "memory");
            const unsigned og = xb_add(&bar[XB_TOP], 1u);
            const unsigned tg = og / nx;
            if (og + 1u == (tg + 1u) * nx) xb_add(&bar[XB_TOPGEN], 1u);
            else XB_SPIN(xb_ld(&bar[XB_TOPGEN]) == tg, bar);
            __builtin_amdgcn_fence(__ATOMIC_ACQUIRE, "agent");
            xb_add(&bar[XB_XGEN(b.x)], 1u);
            asm volatile("s_waitcnt vmcnt(0)" ::: "memory");
        } else {
            XB_SPIN(xb_ld(&bar[XB_XGEN(b.x)]) == gen, bar);
            __builtin_amdgcn_fence(__ATOMIC_ACQUIRE, "agent");
            asm volatile("s_waitcnt vmcnt(0)" ::: "memory");
        }
    }
    __syncthreads();
}

constexpr int CW_MFLAG = 57344, MFLAG_WORDS = 1152;
__device__ __forceinline__ void mflag_arrive(unsigned* w, const XcdBarrier& b) {
    asm volatile("s_waitcnt vmcnt(0)" ::: "memory");
    __syncthreads();
    if (threadIdx.x == 0) {
        const unsigned nloc = b.st[0], nx = b.st[1];
        const unsigned old = xb_add(&w[64 * b.x], 1u);
        if (old + 1u == nloc) {
            __builtin_amdgcn_fence(__ATOMIC_RELEASE, "agent");
            asm volatile("s_waitcnt vmcnt(0)" ::: "memory");
            const unsigned og = xb_add(&w[1024], 1u);
            if (og + 1u == nx) xb_add(&w[1088], 1u);
        }
    }
}
__device__ __forceinline__ void mflag_wait(unsigned* w, const XcdBarrier& b) {
    if (threadIdx.x == 0) {
        unsigned* bar = b.bar;
        XB_SPIN(xb_ld(&w[1088]) == 0u, bar);
        __builtin_amdgcn_fence(__ATOMIC_ACQUIRE, "agent");
        asm volatile("s_waitcnt vmcnt(0)" ::: "memory");
    }
    __syncthreads();
}

constexpr int CW_BAR = 4096;

__device__ __forceinline__ unsigned pk2(float lo, float hi) { return (unsigned)f2bf(lo) | ((unsigned)f2bf(hi) << 16); }

__device__ __forceinline__ unsigned q8pack(float a, float b, float c, float d) {
    const int ia = (int)fminf(fmaxf(rintf(a), -127.f), 127.f), ib = (int)fminf(fmaxf(rintf(b), -127.f), 127.f), ic = (int)fminf(fmaxf(rintf(c), -127.f), 127.f), id = (int)fminf(fmaxf(rintf(d), -127.f), 127.f);
    return (unsigned)(ia & 255) | ((unsigned)(ib & 255) << 8) | ((unsigned)(ic & 255) << 16) | ((unsigned)(id & 255) << 24);
}
template <class Src>
__device__ __forceinline__ void tr_item(const Src& src, bf16* WT, int ldk, int row0, int k0, LAS float* scr, int lane) {
#pragma unroll 8
    for (int i = 0; i < 32; ++i) { const int kk = 2 * i + (lane >> 5); scr[kk * 33 + (lane & 31)] = src(k0 + kk, lane & 31); }
    LDS_WAIT(); asm volatile("" ::: "memory");
    const int c = lane & 7;
#pragma unroll
    for (int j = 0; j < 4; ++j) { const int n = (lane >> 3) + 8 * j; const LAS float* s = scr + (8 * c) * 33 + n;
        u32x4 o; o.x = pk2(s[0 * 33], s[1 * 33]); o.y = pk2(s[2 * 33], s[3 * 33]); o.z = pk2(s[4 * 33], s[5 * 33]); o.w = pk2(s[6 * 33], s[7 * 33]);
        *(u32x4*)(WT + (size_t)(row0 + n) * ldk + k0 + 8 * c) = o; }
    LDS_WAIT(); asm volatile("" ::: "memory");
}
struct SrcWin { const float* w; const float* nw; int nb;
    __device__ __forceinline__ float operator()(int k, int j) const { const int np = nb * 32 + j; return w[(size_t)k * INW + (np < 1536 ? np : np + 8)] * nw[k]; } };
struct SrcWout { const float* w; int n0; const float* snw; const float* hnw;
    __device__ __forceinline__ float operator()(int k, int j) const { return w[(size_t)k * D + n0 + j] * (k < 512 ? snw[k] : hnw[k - 512]); } };
struct SrcPlain { const float* w; int ldn, n0; const float* ks;
    __device__ __forceinline__ float operator()(int k, int j) const { const float v = w[(size_t)k * ldn + n0 + j]; return ks ? v * ks[k] : v; } };
struct SrcGU { const float* wg; const float* wu; const float* nw; int grp;
    __device__ __forceinline__ float operator()(int k, int j) const { const float* w = (j < 16) ? wg : wu; return w[(size_t)k * 256 + grp * 16 + (j & 15)] * nw[k]; } };

constexpr int CW_COLMAX = 65536;
constexpr int IT_WIN = 16 * 112, IT_WOUT = 16 * 32, IT_WGU = 16 * 16 * 16, IT_WD = 16 * 4 * 32, IT_LAYER = IT_WIN + IT_WOUT + IT_WGU + IT_WD;
__device__ __forceinline__ float reduce8(const float (&p)[8], int lane) {
    float a[4], b[2], c;
#pragma unroll
    for (int i = 0; i < 4; ++i) { const bool up = (lane & 32) != 0; const float keep = up ? p[i + 4] : p[i], send = up ? p[i] : p[i + 4]; a[i] = keep + __shfl_xor(send, 32); }
#pragma unroll
    for (int i = 0; i < 2; ++i) { const bool up = (lane & 16) != 0; const float keep = up ? a[i + 2] : a[i], send = up ? a[i] : a[i + 2]; b[i] = keep + __shfl_xor(send, 16); }
    { const bool up = (lane & 8) != 0; const float keep = up ? b[1] : b[0], send = up ? b[0] : b[1]; c = keep + __shfl_xor(send, 8); }
    c += __shfl_xor(c, 4); c += __shfl_xor(c, 2); c += __shfl_xor(c, 1);
    return c;
}
constexpr int P0_WDT = 73728;
__device__ __forceinline__ void p0_prep(const Args& a, LAS unsigned char* lds, int G) {
    const int tid = threadIdx.x, lane = tid & 63, wave = __builtin_amdgcn_readfirstlane(tid >> 6);
    LAS float* scr = (LAS float*)(lds + wave * 8448);
    const int gw = blockIdx.x * NWAVES + wave, NGW = G * NWAVES;
    unsigned char* ws = a.ws;
    {
        LAS bf16* WL = (LAS bf16*)(lds + P0_WDT);
#pragma unroll
        for (int kk = 0; kk < 2; ++kk) { const int k = tid + 512 * kk; const f32x4 w0 = *(const f32x4*)(a.in[2] + (size_t)k * INW + 1536), w1 = *(const f32x4*)(a.in[2] + (size_t)k * INW + 1540); const float nw = a.in[1][k];
            WL[0 * 1024 + k] = f2bf(w0[0] * nw); WL[1 * 1024 + k] = f2bf(w0[1] * nw); WL[2 * 1024 + k] = f2bf(w0[2] * nw); WL[3 * 1024 + k] = f2bf(w0[3] * nw);
            WL[4 * 1024 + k] = f2bf(w1[0] * nw); WL[5 * 1024 + k] = f2bf(w1[1] * nw); WL[6 * 1024 + k] = f2bf(w1[2] * nw); WL[7 * 1024 + k] = f2bf(w1[3] * nw); }
        __syncthreads();
    }
    for (int cb = blockIdx.x; cb < 2 * 112; cb += G) {
        const int l = cb / 112, nb = cb % 112;
        SrcWin s{a.in[2] + (size_t)l * D * INW, a.in[1] + l * D, nb};
        float tv[2][32]; float mx = 0.f;
#pragma unroll
        for (int q = 0; q < 2; ++q)
#pragma unroll
            for (int i = 0; i < 32; ++i) { tv[q][i] = s((2 * wave + q) * 64 + 2 * i + (lane >> 5), lane & 31); mx = fmaxf(mx, fabsf(tv[q][i])); }
        mx = fmaxf(mx, __shfl_xor(mx, 32));
        LAS float* CMX = (LAS float*)(lds + P0_WDT + 16384);
        if (lane < 32) CMX[wave * 32 + lane] = mx;
        __syncthreads();
        const int n = lane >> 1, half = lane & 1;
        float cm = 0.f;
#pragma unroll
        for (int w = 0; w < 8; ++w) cm = fmaxf(cm, CMX[w * 32 + n]);
        const float inv = cm > 0.f ? 127.f / cm : 0.f;
#pragma unroll
        for (int q = 0; q < 2; ++q) { const int kb = 2 * wave + q;
#pragma unroll
            for (int i = 0; i < 32; ++i) { const int kk = 2 * i + (lane >> 5); scr[kk * 33 + (lane & 31)] = tv[q][i]; }
            LDS_WAIT(); asm volatile("" ::: "memory");
            const LAS float* sp = scr + (half * 32) * 33 + n;
            u32x4 o0, o1;
            o0.x = q8pack(sp[0 * 33] * inv, sp[1 * 33] * inv, sp[2 * 33] * inv, sp[3 * 33] * inv);     o0.y = q8pack(sp[4 * 33] * inv, sp[5 * 33] * inv, sp[6 * 33] * inv, sp[7 * 33] * inv);
            o0.z = q8pack(sp[8 * 33] * inv, sp[9 * 33] * inv, sp[10 * 33] * inv, sp[11 * 33] * inv);   o0.w = q8pack(sp[12 * 33] * inv, sp[13 * 33] * inv, sp[14 * 33] * inv, sp[15 * 33] * inv);
            o1.x = q8pack(sp[16 * 33] * inv, sp[17 * 33] * inv, sp[18 * 33] * inv, sp[19 * 33] * inv); o1.y = q8pack(sp[20 * 33] * inv, sp[21 * 33] * inv, sp[22 * 33] * inv, sp[23 * 33] * inv);
            o1.z = q8pack(sp[24 * 33] * inv, sp[25 * 33] * inv, sp[26 * 33] * inv, sp[27 * 33] * inv); o1.w = q8pack(sp[28 * 33] * inv, sp[29 * 33] * inv, sp[30 * 33] * inv, sp[31 * 33] * inv);
            unsigned char* dst = ws + WS_WIN + ((size_t)l * PW + nb * 32 + n) * D + kb * 64 + half * 32;
            *(u32x4*)dst = o0; *(u32x4*)(dst + 16) = o1;
            LDS_WAIT(); asm volatile("" ::: "memory"); }
        if (wave == 0 && half == 0) ((float*)(ws + WS_CS))[l * PW + nb * 32 + n] = cm * (1.f / 127.f);
        __syncthreads();
    }
    for (int it = gw; it < 2 * (IT_LAYER - IT_WIN); it += NGW) {
        const int l = it / (IT_LAYER - IT_WIN); int r = it % (IT_LAYER - IT_WIN);
        if (r < IT_WOUT) { const int kb = r / 32, nb = r % 32; SrcWout s{a.in[11] + (size_t)l * D * D, nb * 32, a.in[8] + l * 512, a.in[10] + l * 512};
            tr_item(s, (bf16*)(ws + WS_WOUT) + (size_t)l * D * D, D, nb * 32, kb * 64, scr, lane); continue; } r -= IT_WOUT;
        if (r < IT_WGU) { const int e = r / 256, kb = (r % 256) / 16, grp = r % 16; const size_t eo = ((size_t)l * 16 + e) * D * 256;
            SrcGU s{a.in[15] + eo, a.in[16] + eo, a.in[12] + l * D, grp};
            tr_item(s, (bf16*)(ws + WS_WGU) + ((size_t)l * 16 + e) * 512 * D, D, grp * 32, kb * 64, scr, lane); continue; } r -= IT_WGU;
        { const int e = r / 128, kb = (r % 128) / 32, nb = r % 32; SrcPlain s{a.in[17] + ((size_t)l * 16 + e) * 256 * D, D, nb * 32, nullptr};
            tr_item(s, (bf16*)(ws + WS_WD) + ((size_t)l * 16 + e) * D * 256, 256, nb * 32, kb * 64, scr, lane); }
    }
    for (int i = blockIdx.x * NTHR + tid; i < 2 * 64 * D; i += G * NTHR) {
        const int l = i / (64 * D), row = (i / D) % 64, k = i % D, c = row & 31; float v = 0.f;
        if (c < 4) v = a.in[13][((size_t)l * D + k) * 4 + c] * a.in[12][l * D + k];
        else if (c < 20) v = a.in[14][((size_t)l * D + k) * 16 + (c - 4)] * a.in[12][l * D + k];
        const bf16 hi = f2bf(v); const bf16 o = (row < 32) ? hi : f2bf(v - bf2f(hi));
        ((bf16*)(ws + WS_WR))[i] = o;
    }
    for (int i = blockIdx.x * NTHR + tid; i < 2 * 16 * D; i += G * NTHR) {
        const int l = i / (16 * D), row = (i / D) % 16, k = i % D;
        const float v = row < 8 ? a.in[2][((size_t)l * D + k) * INW + 1536 + row] * a.in[1][l * D + k] : 0.f;
        ((bf16*)(ws + WS_WDT))[i] = f2bf(v);
    }
    bf16* XB = (bf16*)(ws + WS_XB); float* SSQ = (float*)(ws + WS_SSQ);
    unsigned* XQ = (unsigned*)(ws + WS_XQ); float* SA = (float*)(ws + WS_SA);
    for (int m0 = gw; m0 < T; m0 += 4 * NGW) {
        f32x4 v[4][4];
#pragma unroll
        for (int r = 0; r < 4; ++r) { const int m = m0 + r * NGW; const f32x4* xr = (const f32x4*)(a.in[0] + (size_t)(m < T ? m : m0) * D) + lane;
#pragma unroll
            for (int j = 0; j < 4; ++j) v[r][j] = xr[64 * j]; }
#pragma unroll
        for (int r = 0; r < 4; ++r) { const int m = m0 + r * NGW; float s = 0.f, mx = 0.f;
            unsigned long long* o8 = (unsigned long long*)(XB + (size_t)(m < T ? m : m0) * D) + lane;
            float qv[4][4];
#pragma unroll
            for (int j = 0; j < 4; ++j) { const unsigned lo = cvt_pk_bf16(v[r][j][0], v[r][j][1]), hi = cvt_pk_bf16(v[r][j][2], v[r][j][3]);
                const float q0 = bflo(lo), q1 = bfhi(lo), q2 = bflo(hi), q3 = bfhi(hi); s += (q0 * q0 + q1 * q1) + (q2 * q2 + q3 * q3);
                qv[j][0] = q0; qv[j][1] = q1; qv[j][2] = q2; qv[j][3] = q3; mx = fmaxf(fmaxf(mx, fmaxf(fabsf(q0), fabsf(q1))), fmaxf(fabsf(q2), fabsf(q3)));
                if (m < T) o8[64 * j] = (unsigned long long)lo | ((unsigned long long)hi << 32); }
            s = wave_sum(s);
#pragma unroll
            for (int o = 1; o < 64; o <<= 1) mx = fmaxf(mx, __shfl_xor(mx, o));
            const float inv = mx > 0.f ? 127.f / mx : 0.f;
            if (m < T) {
#pragma unroll
                for (int j = 0; j < 4; ++j) XQ[(size_t)m * 256 + lane + 64 * j] = q8pack(qv[j][0] * inv, qv[j][1] * inv, qv[j][2] * inv, qv[j][3] * inv);
                if (lane < 4) SSQ[(size_t)m * 4 + lane] = lane == 0 ? s : 0.f;
                if (lane == 0) SA[m] = mx * (1.f / 127.f) * rsqrtf(s * (1.f / D) + EPS); }
            float dp[8];
#pragma unroll
            for (int h = 0; h < 8; ++h) { dp[h] = 0.f;
#pragma unroll
                for (int j = 0; j < 4; ++j) { const u32x2 w = *(const LAS u32x2*)(lds + P0_WDT + (h * 1024 + 4 * (lane + 64 * j)) * 2);
                    dp[h] += (qv[j][0] * bflo(w.x) + qv[j][1] * bfhi(w.x)) + (qv[j][2] * bflo(w.y) + qv[j][3] * bfhi(w.y)); } }
            const float dtot = reduce8(dp, lane);
            if (m < T && (lane & 7) == 0) ((float*)(ws + WS_DT))[(size_t)m * 8 + (lane >> 3)] = dtot; }
    }
}

__device__ __forceinline__ void p1_quant_win(const Args& a, LAS unsigned char* lds, int G) {
    int tid = threadIdx.x; asm volatile("" : "+v"(tid));
    const int lane = tid & 63, wave = __builtin_amdgcn_readfirstlane(tid >> 6);
    LAS float* scr = (LAS float*)(lds + wave * 16384);
    const int gw = blockIdx.x * NWAVES + wave, NGW = G * NWAVES;
    unsigned char* ws = a.ws;
    for (int it = gw; it < 2 * IT_WIN; it += NGW) {
        const int l = it / IT_WIN, r = it % IT_WIN, kb = r / 112, nb = r % 112;
        SrcWin s{a.in[2] + (size_t)l * D * INW, a.in[1] + l * D, nb};
#pragma unroll 8
        for (int i = 0; i < 32; ++i) { const int kk = 2 * i + (lane >> 5); scr[kk * 33 + (lane & 31)] = s(kb * 64 + kk, lane & 31); }
        LDS_WAIT(); asm volatile("" ::: "memory");
        const int n = lane >> 1, half = lane & 1;
        const float cm = __uint_as_float(__hip_atomic_load((unsigned*)(ws + WS_CTL) + CW_COLMAX + l * 4096 + nb * 32 + n, __ATOMIC_RELAXED, __HIP_MEMORY_SCOPE_AGENT));
        const float inv = cm > 0.f ? 127.f / cm : 0.f;
        const LAS float* sp = scr + (half * 32) * 33 + n;
        u32x4 o0, o1;
        o0.x = q8pack(sp[0 * 33] * inv, sp[1 * 33] * inv, sp[2 * 33] * inv, sp[3 * 33] * inv);     o0.y = q8pack(sp[4 * 33] * inv, sp[5 * 33] * inv, sp[6 * 33] * inv, sp[7 * 33] * inv);
        o0.z = q8pack(sp[8 * 33] * inv, sp[9 * 33] * inv, sp[10 * 33] * inv, sp[11 * 33] * inv);   o0.w = q8pack(sp[12 * 33] * inv, sp[13 * 33] * inv, sp[14 * 33] * inv, sp[15 * 33] * inv);
        o1.x = q8pack(sp[16 * 33] * inv, sp[17 * 33] * inv, sp[18 * 33] * inv, sp[19 * 33] * inv); o1.y = q8pack(sp[20 * 33] * inv, sp[21 * 33] * inv, sp[22 * 33] * inv, sp[23 * 33] * inv);
        o1.z = q8pack(sp[24 * 33] * inv, sp[25 * 33] * inv, sp[26 * 33] * inv, sp[27 * 33] * inv); o1.w = q8pack(sp[28 * 33] * inv, sp[29 * 33] * inv, sp[30 * 33] * inv, sp[31 * 33] * inv);
        unsigned char* dst = ws + WS_WIN + ((size_t)l * PW + nb * 32 + n) * D + kb * 64 + half * 32;
        *(u32x4*)dst = o0; *(u32x4*)(dst + 16) = o1;
        if (kb == 0 && half == 0) ((float*)(ws + WS_CS))[l * PW + nb * 32 + n] = cm * (1.f / 127.f);
        LDS_WAIT(); asm volatile("" ::: "memory");
    }
}
__device__ __forceinline__ void quant_rows(const Args& a, LAS unsigned char* lds, int G) {
    int tid = threadIdx.x; asm volatile("" : "+v"(tid));
    {
        const u32x4* src = (const u32x4*)(a.ws + WS_WDT + (size_t)16 * D * 2);
#pragma unroll
        for (int kk = 0; kk < 2; ++kk) *(LAS u32x4*)(lds + P0_WDT + (tid + 512 * kk) * 16) = src[tid + 512 * kk];
        __syncthreads();
    }
    GAS unsigned char* wsg_ = (GAS unsigned char*)a.ws; asm volatile("" : "+s"(wsg_)); unsigned char* ws = (unsigned char*)wsg_;
    const int lane = tid & 63, wave = __builtin_amdgcn_readfirstlane(tid >> 6);
    const bf16* XB = (const bf16*)(ws + WS_XB); unsigned char* XQ = ws + WS_XQ; float* SA = (float*)(ws + WS_SA); const float* SSQ = (const float*)(ws + WS_SSQ);
    for (int t0 = blockIdx.x * NWAVES + wave; t0 < T; t0 += 4 * G * NWAVES) {
        u32x4 x0[4], x1[4]; f32x4 sq[4];
#pragma unroll
        for (int r = 0; r < 4; ++r) { const int t = t0 + r * G * NWAVES, tt = t < T ? t : t0; x0[r] = *(const u32x4*)(XB + (size_t)tt * D + lane * 8); x1[r] = *(const u32x4*)(XB + (size_t)tt * D + 512 + lane * 8); sq[r] = *(const f32x4*)(SSQ + (size_t)tt * 4); }
#pragma unroll
        for (int r = 0; r < 4; ++r) { const int t = t0 + r * G * NWAVES;
            const float v[16] = {bflo(x0[r].x), bfhi(x0[r].x), bflo(x0[r].y), bfhi(x0[r].y), bflo(x0[r].z), bfhi(x0[r].z), bflo(x0[r].w), bfhi(x0[r].w), bflo(x1[r].x), bfhi(x1[r].x), bflo(x1[r].y), bfhi(x1[r].y), bflo(x1[r].z), bfhi(x1[r].z), bflo(x1[r].w), bfhi(x1[r].w)};
            float mx = 0.f;
#pragma unroll
            for (int i = 0; i < 16; ++i) mx = fmaxf(mx, fabsf(v[i]));
#pragma unroll
            for (int o = 1; o < 64; o <<= 1) mx = fmaxf(mx, __shfl_xor(mx, o));
            const float inv = mx > 0.f ? 127.f / mx : 0.f;
            if (t < T) { u32x2 q0, q1; q0.x = q8pack(v[0] * inv, v[1] * inv, v[2] * inv, v[3] * inv); q0.y = q8pack(v[4] * inv, v[5] * inv, v[6] * inv, v[7] * inv);
                q1.x = q8pack(v[8] * inv, v[9] * inv, v[10] * inv, v[11] * inv); q1.y = q8pack(v[12] * inv, v[13] * inv, v[14] * inv, v[15] * inv);
                *(u32x2*)(XQ + (size_t)t * D + lane * 8) = q0; *(u32x2*)(XQ + (size_t)t * D + 512 + lane * 8) = q1;
                if (lane == 0) SA[t] = mx * (1.f / 127.f) * rsqrtf(((sq[r][0] + sq[r][1]) + (sq[r][2] + sq[r][3])) * (1.f / D) + EPS); }
            float dp[8];
#pragma unroll
            for (int h = 0; h < 8; ++h) { const u32x4 w0 = *(const LAS u32x4*)(lds + P0_WDT + (h * 1024 + lane * 8) * 2), w1 = *(const LAS u32x4*)(lds + P0_WDT + (h * 1024 + 512 + lane * 8) * 2);
                dp[h] = ((v[0] * bflo(w0.x) + v[1] * bfhi(w0.x)) + (v[2] * bflo(w0.y) + v[3] * bfhi(w0.y))) + ((v[4] * bflo(w0.z) + v[5] * bfhi(w0.z)) + (v[6] * bflo(w0.w) + v[7] * bfhi(w0.w)))
                      + ((v[8] * bflo(w1.x) + v[9] * bfhi(w1.x)) + (v[10] * bflo(w1.y) + v[11] * bfhi(w1.y))) + ((v[12] * bflo(w1.z) + v[13] * bfhi(w1.z)) + (v[14] * bflo(w1.w) + v[15] * bfhi(w1.w))); }
            const float dtot = reduce8(dp, lane);
            if (t < T && (lane & 7) == 0) ((float*)(ws + WS_DT))[(size_t)t * 8 + (lane >> 3)] = dtot; }
    }
}

enum { PH_PREP = 0, PH_L0 = 1, PHL_INPROJ = 0, PHL_PRE = 1, PHL_SEQ = 2, PHL_NORM = 3, PHL_OUTPROJ = 4, PHL_ROUTER = 5, PHL_UP = 6, PHL_DOWN = 7, PHL_COUNT = 8, PH_FINAL = PH_L0 + 2 * PHL_COUNT, PH_COUNT = PH_FINAL + 1 };

__global__ void __launch_bounds__(NTHR, 2) mega(Args args) {
    extern __shared__ __attribute__((aligned(16))) unsigned char lds_raw[];
    LAS unsigned char* lds = (LAS unsigned char*)lds_raw;
    const int G = gridDim.x;
    for (int u = threadIdx.x; u < (LDS_BYTES - LDSCTL_OFF) / 4; u += NTHR) ((LAS unsigned*)(lds + LDSCTL_OFF))[u] = 0u;
    __syncthreads();
    const int lo = args.ph_lo, hi = args.ph_hi;
    XcdBarrier bar; bar.bar = (unsigned*)(args.ws + WS_CTL) + CW_BAR + args.li * XCD_BAR_WORDS; bar.x = 0; bar.st = nullptr;
    if (hi - lo > 1) bar = xcd_barrier_post(bar.bar, (volatile LAS unsigned*)(lds + MISC_OFF) + 8);
#ifndef PHMASK
#define PHMASK 0xffffffffu
#endif
#ifndef SEQX
#define SEQX 0
#endif
#ifndef SEQNC
#define SEQNC true
#endif
#ifndef DUPMASK
#define DUPMASK 0u
#endif
#define DUP(bit) ((DUPMASK >> (bit)) & 1u)
#define IN(k) (lo <= (k) && (k) < hi)
#define ON(bit) ((PHMASK >> (bit)) & 1u)
#define SEAM(k) do { if (IN(k) && IN((k) + 1)) xcd_barrier(bar); } while (0)
#define OPAQUE_WS() GAS unsigned char* wsg_ = (GAS unsigned char*)args.ws; asm volatile("" : "+s"(wsg_)); unsigned char* ws = (unsigned char*)wsg_
    if (DUP(0) && IN(PH_PREP)) { p0_prep(args, lds, G); xcd_barrier(bar); }
    if (ON(0) && IN(PH_PREP)) { p0_prep(args, lds, G); }
    SEAM(PH_PREP);
    int vb = (int)blockIdx.x;
    if (IN(PH_PREP) && IN(PH_PREP + 1)) {
        volatile LAS unsigned* st = (volatile LAS unsigned*)(lds + MISC_OFF) + 8;
        if (threadIdx.x == 0) { bool ok = (G == 256);
            unsigned cn[16];
#pragma unroll
            for (unsigned j = 0; j < 16; ++j) cn[j] = xb_ld(&bar.bar[XB_XCNT(j)]);
#pragma unroll
            for (unsigned j = 0; j < 16; ++j) ok &= (j < 8 ? cn[j] == 32u : cn[j] == 0u);
            st[3] = (ok && bar.x < 8u && st[2] < 32u) ? (bar.x + 8u * st[2]) : blockIdx.x; }
        __syncthreads();
        vb = __builtin_amdgcn_readfirstlane((int)st[3]);
    }
    for (int l = 0; l < 2; ++l) {
        const int pb = PH_L0 + l * PHL_COUNT;
        for (int rep = DUP(1) ? 0 : 1; rep < 2; ++rep)
        if (ON(1) && IN(pb + PHL_INPROJ)) { OPAQUE_WS(); if (rep == 1 && DUP(1)) xcd_barrier(bar);
            if (l == 1) { quant_rows(args, lds, G); xcd_barrier(bar); }
            I8Prob P; P.A = (const bf16*)(ws + WS_XQ); P.Bt = (const bf16*)(ws + WS_WIN + (size_t)l * PW * D); P.K = D / 2; P.lda = D / 2; P.ldb = D / 2; P.so.init(T, PW, G, vb);
            EpiProjI8 E{(bf16*)(ws + WS_PROJ), PW, (const float*)(ws + WS_SA), (const float*)(ws + WS_CS) + l * PW, false, false};
#ifndef XMODE
#define XMODE 0
#endif
            if (DUP(1) && rep == 0) { EpiProjI8 E2 = E; E2.nostore = (XMODE & 8) != 0; E2.dense = (XMODE & 16) != 0; gemm_phase<EpiProjI8, I8Prob, XMODE>(lds, P, E2); } else
            gemm_phase<EpiProjI8, I8Prob>(lds, P, E);
        }
        SEAM(pb + PHL_INPROJ);
        #ifndef PREMODE
#define PREMODE 7
#endif
        if (DUP(6) && IN(pb + PHL_PRE)) { pre_phase(args, l, lds, G, PREMODE); xcd_barrier(bar); }
        if (ON(6) && IN(pb + PHL_PRE)) pre_phase(args, l, lds, G);
        SEAM(pb + PHL_PRE);
        if (DUP(7) && IN(pb + PHL_SEQ)) { seq_phase(args, lds, G, vb, true, SEQNC, SEQX); xcd_barrier(bar); }
        if (ON(7) && IN(pb + PHL_SEQ)) seq_phase(args, lds, G, vb);
        SEAM(pb + PHL_SEQ);
        for (int rep = DUP(2) ? 0 : 1; rep < 2; ++rep)
        if (ON(2) && IN(pb + PHL_OUTPROJ)) { OPAQUE_WS(); if (rep == 1 && DUP(2)) xcd_barrier(bar);
            PlainProbT<true, true> P; P.A = (const bf16*)(ws + WS_YA); P.Bt = (const bf16*)(ws + WS_WOUT) + (size_t)l * D * D; P.K = D; P.lda = D; P.ldb = D; P.so.init(T, D, G, vb);
            P.scl = (const float*)(ws + WS_SSQM);
            EpiResid E{(bf16*)(ws + WS_XB), D, rep == 0, (const float*)(ws + WS_SCL)};
            gemm_phase<EpiResid, PlainProbT<true, true>>(lds, P, E);
        }
        SEAM(pb + PHL_OUTPROJ);
        if (ON(3) && IN(pb + PHL_ROUTER)) { OPAQUE_WS(); router_phase(ws, l, lds, G); }
        SEAM(pb + PHL_ROUTER);
        if (ON(4) && IN(pb + PHL_UP) && IN(pb + PHL_DOWN)) { OPAQUE_WS();
            LAS int* tbl = (LAS int*)(lds + TBL_OFF); moe_table((const unsigned*)(ws + WS_CTL) + CW_CNT + l * 64, tbl);
            unsigned* fl = (unsigned*)(ws + WS_CTL) + CW_MFLAG + l * 2 * MFLAG_WORDS;
            const int n = 4 * __builtin_amdgcn_readfirstlane(tbl[24]);
            {   UpProb P; P.A = (const bf16*)(ws + WS_XB); P.W = (const bf16*)(ws + WS_WGU) + (size_t)l * 16 * 512 * D; P.list = (const int*)(ws + WS_LIST); P.tbl = tbl;
                P.K = D; P.lda = D; P.ldb = D; P.G = G; P.c = vb;
                EpiHid E{(bf16*)(ws + WS_HID), (const int*)(ws + WS_LIST), (const f32x4*)(ws + WS_TOKINFO)};
                for (int part = 0; part < 2; ++part) {
                    P.i0 = part * 2; P.hi = part ? 0x7fffffff : 2 * G;
                    gemm_phase<EpiHid, UpProb>(lds, P, E);
                    mflag_arrive(fl + part * MFLAG_WORDS, bar);
                }
            }
            {   int c0 = n - 2 * G; c0 = c0 < 0 ? 0 : c0; if (c0 >= G) c0 = 0;
                const int Gd = G - c0, cd = vb - c0;
                DownProb P; P.A = (const bf16*)(ws + WS_HID); P.W = (const bf16*)(ws + WS_WD) + (size_t)l * 16 * D * 256; P.tbl = tbl;
                P.K = 512; P.lda = 512; P.ldb = 256; P.G = Gd; P.c = cd;
                EpiDown E{(bf16*)(ws + WS_XB), (const int*)(ws + WS_LIST), (float*)(ws + WS_SSQ), false};
                for (int part = 0; part < 2; ++part) {
                    const int ifirst = cd >= 0 ? (2 * G - cd + Gd - 1) / Gd : 0;
                    P.i0 = part ? (ifirst < 0 ? 0 : ifirst) : 0; P.hi = part ? 0x7fffffff : 2 * G;
                    if (cd >= 0) mflag_wait(fl + part * MFLAG_WORDS, bar);
                    gemm_phase<EpiDown, DownProb>(lds, P, E);
                }
            }
        }
        SEAM(pb + PHL_DOWN);
    }
    if (IN(PH_FINAL)) {
        OPAQUE_WS(); int tid = threadIdx.x; asm volatile("" : "+v"(tid));
        const int lane = tid & 63, wave = __builtin_amdgcn_readfirstlane(tid >> 6);
        const bf16* XB = (const bf16*)(ws + WS_XB); const float* fw = args.in[18];
        float w[16];
#pragma unroll
        for (int j = 0; j < 2; ++j)
#pragma unroll
            for (int i = 0; i < 8; ++i) w[j * 8 + i] = fw[j * 512 + lane * 8 + i];
        for (int t0 = blockIdx.x * NWAVES + wave; t0 < T; t0 += 4 * G * NWAVES) {
            u32x4 a[4], b[4];
#pragma unroll
            for (int r = 0; r < 4; ++r) { const int t = t0 + r * G * NWAVES, tt = t < T ? t : t0; a[r] = *(const u32x4*)(XB + (size_t)tt * D + lane * 8); b[r] = *(const u32x4*)(XB + (size_t)tt * D + 512 + lane * 8); }
#pragma unroll
            for (int r = 0; r < 4; ++r) { const int t = t0 + r * G * NWAVES;
                float v[16] = {bflo(a[r].x), bfhi(a[r].x), bflo(a[r].y), bfhi(a[r].y), bflo(a[r].z), bfhi(a[r].z), bflo(a[r].w), bfhi(a[r].w), bflo(b[r].x), bfhi(b[r].x), bflo(b[r].y), bfhi(b[r].y), bflo(b[r].z), bfhi(b[r].z), bflo(b[r].w), bfhi(b[r].w)};
                float s = 0.f;
#pragma unroll
                for (int i = 0; i < 16; ++i) s += v[i] * v[i];
                s = rsqrtf(wave_sum(s) * (1.f / D) + EPS);
                if (t < T) { float* o = args.out + (size_t)t * D + lane * 8;
                    *(f32x4*)(o) = (f32x4){v[0] * s * w[0], v[1] * s * w[1], v[2] * s * w[2], v[3] * s * w[3]};
                    *(f32x4*)(o + 4) = (f32x4){v[4] * s * w[4], v[5] * s * w[5], v[6] * s * w[6], v[7] * s * w[7]};
                    *(f32x4*)(o + 512) = (f32x4){v[8] * s * w[8], v[9] * s * w[9], v[10] * s * w[10], v[11] * s * w[11]};
                    *(f32x4*)(o + 516) = (f32x4){v[12] * s * w[12], v[13] * s * w[13], v[14] * s * w[14], v[15] * s * w[15]}; } }
        }
    }
#undef IN
#undef SEAM
}
extern "C" void kernel_launch(void* const* d_in, const int* in_sizes, int n_in, void* d_out, int out_size, void* d_ws, size_t ws_size, hipStream_t stream) {
    static int grid = 0;
    if (grid == 0) {
        int dev = 0, cus = 0;
        if (hipGetDevice(&dev) != hipSuccess || hipDeviceGetAttribute(&cus, hipDeviceAttributeMultiprocessorCount, dev) != hipSuccess) { fprintf(stderr, "kernel_launch: device query failed\n"); grid = -1; return; }
        if (hipFuncSetAttribute((const void*)mega, hipFuncAttributeMaxDynamicSharedMemorySize, LDS_BYTES) != hipSuccess) { fprintf(stderr, "kernel_launch: hipFuncSetAttribute failed\n"); grid = -1; return; }
        (void)hipGetLastError();
        grid = cus;
    }
    if (grid < 0) return;
    unsigned char* ws = (unsigned char*)d_ws;
    (void)hipMemsetAsync(ws + WS_CTL, 0, CTL_ZERO_BYTES, stream);
    Args a{};
    for (int i = 0; i < 19; ++i) a.in[i] = (const float*)d_in[i];
    a.out = (float*)d_out; a.ws = ws;
    auto run = [&](int lo, int hi, int li) { a.ph_lo = lo; a.ph_hi = hi; a.li = li; hipLaunchKernelGGL(mega, dim3(grid), dim3(NTHR), LDS_BYTES, stream, a); };
    run(PH_PREP, PH_COUNT, 0);
}
```

```cpp
#include <hip/hip_runtime.h>
#include <cstdio>
#include <cstdint>

typedef unsigned short bf16;
constexpr int T = 32768, D = 1024, SEQ = 8192, NB = 4;
constexpr int INW = 3592, PW = 3584;
constexpr float EPS = 1e-6f;
constexpr size_t MiB = 1u << 20;
constexpr size_t WS_CTL = 0, CTL_ZERO_BYTES = 64 * 1024;
constexpr size_t WS_DT = 1 * MiB;
constexpr size_t WS_SA = 2 * MiB;
constexpr size_t WS_CS = 2 * MiB + 256 * 1024;
constexpr size_t WS_SSQ = 3 * MiB;
constexpr size_t WS_TOKINFO = 5 * MiB;
constexpr size_t WS_LIST = 6 * MiB;
constexpr size_t WS_E1 = 9 * MiB;
constexpr size_t WS_BLKDEC = 10 * MiB;
constexpr size_t WS_WIN = 12 * MiB;
constexpr size_t WS_WOUT = 26 * MiB;
constexpr size_t WS_WGU = 30 * MiB;
constexpr size_t WS_WD = 62 * MiB;
constexpr size_t WS_WR = 78 * MiB;
constexpr size_t WS_WDT = 79 * MiB;
constexpr size_t WS_XB = 84 * MiB;
constexpr size_t WS_PROJ = 148 * MiB;
constexpr size_t WS_YA = 372 * MiB;
constexpr size_t WS_XQ = WS_YA;
constexpr size_t WS_YRAW = 372 * MiB;
constexpr size_t WS_BCT = 436 * MiB, WS_CC = 452 * MiB, WS_HID = 468 * MiB;

__device__ __forceinline__ float bf2f(bf16 v) { return __uint_as_float((unsigned)v << 16); }
__device__ __forceinline__ bf16 f2bf(float f) { unsigned u = __float_as_uint(f); return (bf16)((u + 0x7fffu + ((u >> 16) & 1u)) >> 16); }
__device__ __forceinline__ float rcpf(float x) { return __builtin_amdgcn_rcpf(x); }
__device__ __forceinline__ float siluf(float x) { return x * rcpf(1.f + __expf(-x)); }
__device__ __forceinline__ float sigmf(float x) { return rcpf(1.f + __expf(-x)); }
__device__ __forceinline__ float softplusf(float x) { const float e = __expf(x), u = 1.f + e; return x > 20.f ? x : (u == 1.f ? e : __logf(u) * (e * rcpf(u - 1.f))); }
__device__ __forceinline__ float wave_sum(float v) {
#pragma unroll
    for (int o = 1; o < 64; o <<= 1) v += __shfl_xor(v, o);
    return v;
}

__device__ __forceinline__ size_t perm_idx(int t, int c, int ld) {
    return (size_t)((t & ~31) + ((c & 255) >> 3)) * ld + (c & ~255) + ((t & 31) << 3) + (c & 7);
}
#define LAS __attribute__((address_space(3)))
#define GAS __attribute__((address_space(1)))
#define ST_WT16(ptr, val) asm volatile("global_store_dwordx4 %0, %1, off sc0 sc1\n\ts_nop 1" :: "v"((GAS void*)(ptr)), "v"(val) : "memory")
typedef short bf16x8 __attribute__((ext_vector_type(8)));
typedef float f32x4 __attribute__((ext_vector_type(4)));
typedef unsigned u32x4 __attribute__((ext_vector_type(4)));
typedef unsigned u32x2 __attribute__((ext_vector_type(2)));
typedef int i32x4 __attribute__((ext_vector_type(4)));
typedef GAS unsigned gu32;
#define RLX_AGENT __ATOMIC_RELAXED, __HIP_MEMORY_SCOPE_AGENT
#define LDS_WAIT() asm volatile("s_waitcnt lgkmcnt(0)" ::: "memory")
#define VM_WAIT() asm volatile("s_waitcnt vmcnt(0)" ::: "memory")
struct Args { const float* in[19]; float* out; unsigned char* ws; int ph_lo, ph_hi, li, pad; };
constexpr int NWAVES = 8, NTHR = 512;
constexpr int BM = 256, BK = 64, HALF = 128, HTB = HALF * BK * 2, STAGE_BYTES = 8 * HTB, NXCD = 8, WGM = 8;
constexpr int RING_BYTES = 131072, LDSCTL_OFF = RING_BYTES, MISC_OFF = LDSCTL_OFF + 320, LDS_BYTES = 147456;
constexpr int SIDE_OFF = 136192;
constexpr int SCLT_OFF = 135936;

__host__ __device__ __forceinline__ int lds_byte(int r, int c) { const int st = (r >> 4) * 2 + (c >> 5), rr = r & 15, cc = c & 31, ob = rr * 64 + cc * 2; return st * 1024 + (ob ^ (((ob >> 9) & 1) << 5)); }
__host__ __device__ __forceinline__ void stage_rc(int b, int& R, int& C) { const int st = b / 1024, sb = b % 1024, swz = sb ^ (((sb >> 9) & 1) << 5); R = (st >> 1) * 16 + swz / 64; C = (st & 1) * 32 + (swz % 64) / 2; }
__host__ __device__ __forceinline__ int perm32(int rho) { const int n = rho >> 4, i = rho & 15; return 8 * (i >> 2) + 4 * n + (i & 3); }
typedef __bf16 bf16x2_t __attribute__((ext_vector_type(2)));
typedef float f32x2_t __attribute__((ext_vector_type(2)));
__device__ __forceinline__ unsigned cvt_pk_bf16(float lo, float hi) { const f32x2_t v = {lo, hi}; const bf16x2_t r = __builtin_convertvector(v, bf16x2_t); return __builtin_bit_cast(unsigned, r); }
__device__ __forceinline__ float bflo(unsigned w) { return __uint_as_float(w << 16); }
__device__ __forceinline__ float bfhi(unsigned w) { return __uint_as_float(w & 0xffff0000u); }

struct Unit { int pm, pn; };
struct StaticOrder {
    int nM, nN, nwg, G, c;
    __device__ void init(int M, int N, int G_, int c_) { nM = M / BM; nN = N / BM; nwg = nM * nN; G = G_; c = c_; }
    __device__ bool next(int i, Unit& u) const {
        const long L = (long)i * G + c; if (L >= nwg) return false;
        int wgid = (int)L; { const int q = nwg / NXCD, r = nwg % NXCD, xcd = wgid % NXCD, off = wgid / NXCD; wgid = (xcd < r ? xcd * (q + 1) : r * (q + 1) + (xcd - r) * q) + off; }
        const int nig = WGM * nN, gid = wgid / nig, fm = gid * WGM, gsz = (nM - fm) < WGM ? (nM - fm) : WGM;
        u.pm = fm + ((wgid % nig) % gsz); u.pn = (wgid % nig) / gsz; return true;
    }
};
template <bool KSC_, bool APERM_ = false> struct PlainProbT {
    typedef ::Unit Unit; static constexpr bool GATHER = false, KSC = KSC_, I8 = false, APERM = APERM_;
    const bf16* A; const bf16* Bt; int K, lda, ldb; StaticOrder so; const float* scl;
    __device__ __forceinline__ bool next(int i, Unit& u) const { return so.next(i, u); }
    __device__ __forceinline__ const char* a_base(const Unit& u) const { return (const char*)A + (size_t)u.pm * BM * lda * 2; }
    __device__ __forceinline__ const char* b_base(const Unit& u) const { return (const char*)Bt + (size_t)u.pn * BM * ldb * 2; }
    __device__ __forceinline__ const char* b_at(const char* cB, const Unit&, int t) const { return cB + (size_t)t * (BK * 2); }
    __device__ __forceinline__ void a_offs(const Unit&, const int (&)[2], const int (&)[2], unsigned (&)[2][2]) const {}
};
typedef PlainProbT<false> PlainProb;
struct I8Prob {
    typedef ::Unit Unit; static constexpr bool GATHER = false, KSC = false, I8 = true, APERM = false;
    const bf16* A; const bf16* Bt; int K, lda, ldb; StaticOrder so;
    __device__ __forceinline__ bool next(int i, Unit& u) const { return so.next(i, u); }
    __device__ __forceinline__ const char* a_base(const Unit& u) const { return (const char*)A + (size_t)u.pm * BM * lda * 2; }
    __device__ __forceinline__ const char* b_base(const Unit& u) const { return (const char*)Bt + (size_t)u.pn * BM * ldb * 2; }
    __device__ __forceinline__ const char* b_at(const char* cB, const Unit&, int t) const { return cB + (size_t)t * (BK * 2); }
    __device__ __forceinline__ void a_offs(const Unit&, const int (&)[2], const int (&)[2], unsigned (&)[2][2]) const {}
};

__device__ __forceinline__ float rstd_from_ssq(const float* ssq, int row) {
    const f32x4 a = *(const f32x4*)(ssq + (size_t)row * 4);
    return rsqrtf(((a[0] + a[1]) + (a[2] + a[3])) * (1.f / D) + EPS);
}
struct EpiProj {
    typedef f32x4 acc_t; static constexpr bool PERM = true, SIDE = false;
    bf16* O; int ldc; const float* ssq;
    __device__ __forceinline__ void operator()(const f32x4 (&acc)[2][2][4][2], const Unit& u, int wr, int wc, int fr_, int fq_, LAS unsigned char*) const {
        int fr = fr_, fq = fq_; asm volatile("" : "+v"(fr), "+v"(fq));
        const int row0 = u.pm * BM + wr * 64 + fr, col0 = u.pn * BM + wc * 32 + 8 * fq;
        float rsv[2][4];
#pragma unroll
        for (int ai = 0; ai < 2; ++ai)
#pragma unroll
            for (int m = 0; m < 4; ++m) rsv[ai][m] = rstd_from_ssq(ssq, row0 + ai * HALF + m * 16);
        asm volatile("" ::: "memory");
#pragma unroll
        for (int ai = 0; ai < 2; ++ai)
#pragma unroll
            for (int m = 0; m < 4; ++m) { const int r = row0 + ai * HALF + m * 16; const float rs = rsv[ai][m]; bf16* rowp = O + (size_t)r * ldc + col0;
#pragma unroll
                for (int bj = 0; bj < 2; ++bj) { const f32x4 v0 = acc[ai][bj][m][0] * rs, v1 = acc[ai][bj][m][1] * rs;
                    u32x4 w; w.x = cvt_pk_bf16(v0[0], v0[1]); w.y = cvt_pk_bf16(v0[2], v0[3]); w.z = cvt_pk_bf16(v1[0], v1[1]); w.w = cvt_pk_bf16(v1[2], v1[3]);
                    *(u32x4*)(rowp + bj * HALF) = w; }
                asm volatile("" ::: "memory"); }
    }
};
struct EpiProjI8 {
    typedef i32x4 acc_t; static constexpr bool PERM = true, SIDE = true;
    bf16* O; int ldc; const float* sa; const float* cs; bool nostore; bool dense;
    __device__ __forceinline__ void side_issue(const Unit& u, LAS unsigned char* side, int wid, int lane) const {
        const int e = wid * 64 + lane;
        const float* src = wid < 4 ? sa + u.pm * BM + e : cs + u.pn * BM + (e - 256);
        __builtin_amdgcn_global_load_lds((const unsigned*)src, (LAS unsigned*)(side + wid * 256), 4, 0, 0);
    }
    __device__ __forceinline__ void operator()(const i32x4 (&acc)[2][2][4][2], const Unit& u, int wr, int wc, int fr_, int fq_, LAS unsigned char*, LAS unsigned char* side) const {
        int fr = fr_, fq = fq_; asm volatile("" : "+v"(fr), "+v"(fq));
        const int row0 = u.pm * BM + wr * 64 + fr, col0 = u.pn * BM + wc * 32 + 8 * fq;
        f32x4 c0[2][2];
#pragma unroll
        for (int bj = 0; bj < 2; ++bj)
#pragma unroll
            for (int n = 0; n < 2; ++n) c0[bj][n] = *(const LAS f32x4*)(side + (256 + wc * 32 + 8 * fq + bj * HALF + 4 * n) * 4);
        const bool gate = ((0x3003u >> u.pn) & 1u) != 0; const size_t bjstep = gate ? (size_t)16 * ldc : (size_t)HALF;
        float rsv[2][4];
#pragma unroll
        for (int ai = 0; ai < 2; ++ai)
#pragma unroll
            for (int m = 0; m < 4; ++m) rsv[ai][m] = ((const LAS float*)side)[wr * 64 + fr + ai * HALF + m * 16];
        asm volatile("" ::: "memory");
#pragma unroll
        for (int ai = 0; ai < 2; ++ai)
#pragma unroll
            for (int m = 0; m < 4; ++m) { const int r = row0 + ai * HALF + m * 16; const float rs = rsv[ai][m]; bf16* rowp = gate ? O + perm_idx(r, col0, ldc) : O + (size_t)r * ldc + col0;
#pragma unroll
                for (int bj = 0; bj < 2; ++bj) { const i32x4 a0 = acc[ai][bj][m][0], a1 = acc[ai][bj][m][1];
                    const f32x4 v0 = (f32x4){(float)a0[0], (float)a0[1], (float)a0[2], (float)a0[3]} * c0[bj][0] * rs, v1 = (f32x4){(float)a1[0], (float)a1[1], (float)a1[2], (float)a1[3]} * c0[bj][1] * rs;
                    u32x4 w; w.x = cvt_pk_bf16(v0[0], v0[1]); w.y = cvt_pk_bf16(v0[2], v0[3]); w.z = cvt_pk_bf16(v1[0], v1[1]); w.w = cvt_pk_bf16(v1[2], v1[3]);
                    if (dense) *(u32x4*)(O + (size_t)(u.pm * 14 + u.pn) * 65536 + (size_t)(((wr * 4 + wc) * 16 + (ai * 4 + m) * 2 + bj) * 512 + (fq * 16 + fr) * 8)) = w;
                    else if (!nostore) ST_WT16(rowp + bj * bjstep, w); else asm volatile("" :: "v"(w.x), "v"(w.y), "v"(w.z), "v"(w.w)); }
                asm volatile("" ::: "memory"); }
    }
};
struct EpiResid {
    typedef f32x4 acc_t; static constexpr bool PERM = true, SIDE = false;
    bf16* X; int ldc; bool dry; const float* scl;
    __device__ __forceinline__ void operator()(const f32x4 (&acc)[2][2][4][2], const Unit& u, int wr, int wc, int fr_, int fq_, LAS unsigned char* lds) const {
        int fr = fr_, fq = fq_; asm volatile("" : "+v"(fr), "+v"(fq));
        const int row0 = u.pm * BM + wr * 64 + fr, col0 = u.pn * BM + wc * 32 + 8 * fq;
        u32x4 ov[2][4][2];
#pragma unroll
        for (int ai = 0; ai < 2; ++ai)
#pragma unroll
            for (int m = 0; m < 4; ++m)
#pragma unroll
                for (int bj = 0; bj < 2; ++bj) ov[ai][m][bj] = *(const u32x4*)(X + (size_t)(row0 + ai * HALF + m * 16) * ldc + col0 + bj * HALF);
        asm volatile("" ::: "memory");
#pragma unroll
        for (int ai = 0; ai < 2; ++ai)
#pragma unroll
            for (int m = 0; m < 4; ++m) { const int r = row0 + ai * HALF + m * 16; bf16* rowp = X + (size_t)r * ldc + col0; const float fs = scl ? ((const LAS float*)(lds + SCLT_OFF))[(wr * 64 + fr + ai * HALF + m * 16) * 8 + 5] : 1.f;
#pragma unroll
                for (int bj = 0; bj < 2; ++bj) { const u32x4 o = ov[ai][m][bj]; const f32x4 v0 = acc[ai][bj][m][0] * fs, v1 = acc[ai][bj][m][1] * fs;
                    u32x4 w; w.x = cvt_pk_bf16(bflo(o.x) + v0[0], bfhi(o.x) + v0[1]); w.y = cvt_pk_bf16(bflo(o.y) + v0[2], bfhi(o.y) + v0[3]);
                    w.z = cvt_pk_bf16(bflo(o.z) + v1[0], bfhi(o.z) + v1[1]); w.w = cvt_pk_bf16(bflo(o.w) + v1[2], bfhi(o.w) + v1[3]);
                    if (!dry) *(u32x4*)(rowp + bj * HALF) = w; else asm volatile("" :: "v"(w.x), "v"(w.y), "v"(w.z), "v"(w.w)); }
                asm volatile("" ::: "memory"); }
    }
};

__device__ __forceinline__ f32x4 ksc_calc(const float* src, int half) {
    float v[32];
#pragma unroll
    for (int i = 0; i < 32; ++i) v[i] = src[(size_t)i * T];
    float q[4];
#pragma unroll
    for (int i = 0; i < 4; ++i) q[i] = ((v[8 * i] + v[8 * i + 1]) + (v[8 * i + 2] + v[8 * i + 3])) + ((v[8 * i + 4] + v[8 * i + 5]) + (v[8 * i + 6] + v[8 * i + 7]));
    const float sA = rsqrtf((half ? q[0] : q[0] + q[1]) * (half ? 1.f / 128.f : 1.f / 256.f) + EPS), sB = rsqrtf((half ? q[1] : q[2] + q[3]) * (half ? 1.f / 128.f : 1.f / 256.f) + EPS);
    const float sC = rsqrtf(q[2] * (1.f / 128.f) + EPS), sD = rsqrtf(q[3] * (1.f / 128.f) + EPS);
    const float n2 = __shfl_xor(sA, 1), n3 = __shfl_xor(sB, 1), n4 = __shfl_xor(sC, 1);
    const f32x4 o = half ? (f32x4){sC * __builtin_amdgcn_rcpf(sD), sD, 0.f, 0.f} : (f32x4){sA * __builtin_amdgcn_rcpf(sB), sB * __builtin_amdgcn_rcpf(n2), n2 * __builtin_amdgcn_rcpf(n3), n3 * __builtin_amdgcn_rcpf(n4)};
    return o;
}
template <bool I8> __device__ __forceinline__ f32x4 mma_any(bf16x8 a, bf16x8 b, f32x4 c) { return __builtin_amdgcn_mfma_f32_16x16x32_bf16(a, b, c, 0, 0, 0); }
template <bool I8> __device__ __forceinline__ i32x4 mma_any(bf16x8 a, bf16x8 b, i32x4 c) { return __builtin_amdgcn_mfma_i32_16x16x64_i8(__builtin_bit_cast(i32x4, a), __builtin_bit_cast(i32x4, b), c, 0, 0, 0); }
template <class Epi, class Prob, int XM = 0>
__device__ __forceinline__ void gemm_phase(LAS unsigned char* lds, const Prob& S, const Epi& E) {
    typedef typename Prob::Unit PUnit;
    int tid = threadIdx.x; asm volatile("" : "+v"(tid));
    const int wid = __builtin_amdgcn_readfirstlane(tid >> 6), lane = tid & 63, wr = wid >> 2, wc = wid & 3, fr = lane & 15, fq = lane >> 4;
    const int K = S.K, nt = K / BK;
    int R[2], C[2]; unsigned voffA[2], voffB[2];
#pragma unroll
    for (int i = 0; i < 2; ++i) { stage_rc(tid * 16 + i * 8192, R[i], C[i]); const int Rb = Epi::PERM ? ((R[i] & ~31) + perm32(R[i] & 31)) : R[i];
        voffA[i] = Prob::APERM ? (unsigned)(((R[i] & ~31) + (C[i] >> 3)) * S.lda + ((R[i] & 31) << 3)) * 2u : (unsigned)(R[i] * S.lda + C[i]) * 2u; voffB[i] = (unsigned)(Rb * S.ldb + C[i]) * 2u; }
    const size_t kstep = (size_t)(BK * 2);
#define PG8_A_AT(base, t) (Prob::APERM ? (base) + (size_t)((t) & 3) * ((size_t)8 * S.lda * 2) + (size_t)((t) >> 2) * 512 : (base) + (size_t)(t) * kstep)
    const size_t hstepA = (size_t)HALF * S.lda * 2, hstepB = (size_t)HALF * S.ldb * 2;
    const unsigned ldsw = (unsigned)wid * 1024u;
    const int aoff = lds_byte(wr * 64 + fr, fq * 8), boff = lds_byte(wc * 32 + fr, fq * 8);
#define PG8_SA(b, h) (((b) * 2 + (h)) * HTB)
#define PG8_SB(b, h) ((4 + (b) * 2 + (h)) * HTB)
#define PG8_STAGE(bufoff, gbase, voff) do { if constexpr (!(XM & 2)) _Pragma("unroll") for (int _i = 0; _i < 2; ++_i) \
        __builtin_amdgcn_global_load_lds((const unsigned*)((const char*)(gbase) + (voff)[_i]), (LAS unsigned*)(lds + (bufoff) + ldsw + _i * 8192), 16, 0, 0); } while (0)
#define PG8_STAGE_A(b, h, ptr, offs) do { if constexpr (Prob::GATHER) PG8_STAGE(PG8_SA(b, h), ptr, offs[h]); else PG8_STAGE(PG8_SA(b, h), (ptr) + (h) * hstepA, voffA); } while (0)
#define PG8_LDA(dst, b, h) do { _Pragma("unroll") for (int m = 0; m < 4; ++m) _Pragma("unroll") for (int k = 0; k < 2; ++k) dst[m][k] = *(const LAS bf16x8*)(lds + PG8_SA(b, h) + aoff + m * 2048 + k * 1024); } while (0)
#define PG8_LDB(dst, b, h) do { _Pragma("unroll") for (int n = 0; n < 2; ++n) _Pragma("unroll") for (int k = 0; k < 2; ++k) dst[n][k] = *(const LAS bf16x8*)(lds + PG8_SB(b, h) + boff + n * 2048 + k * 1024); } while (0)
#define PG8_MMA(ai, bj, At, Bt) do { __builtin_amdgcn_s_setprio(1); _Pragma("unroll") for (int m = 0; m < 4; ++m) _Pragma("unroll") for (int n = 0; n < 2; ++n) _Pragma("unroll") for (int k = 0; k < 2; ++k) \
        { if constexpr (XM & 1) asm volatile("" :: "v"(Bt[n][k]), "v"(At[m][k])); else acc[ai][bj][m][n] = mma_any<Prob::I8>(Bt[n][k], At[m][k], acc[ai][bj][m][n]); } __builtin_amdgcn_s_setprio(0); } while (0)
#define PG8_SCLCALC(u) do { if constexpr (Prob::KSC) sclv = ksc_calc(S.scl + (size_t)((tid & 1) * 32) * T + (u).pm * BM + (tid >> 1), tid & 1); } while (0)
#define PG8_SCLSTORE() do { if constexpr (Prob::KSC) *(LAS f32x4*)(lds + SCLT_OFF + tid * 16) = sclv; } while (0)
#define PG8_WAIT_V(n) asm volatile("s_waitcnt vmcnt(" #n ")" ::: "memory")
#define PG8_WAIT_L(n) asm volatile("s_waitcnt lgkmcnt(" #n ")" ::: "memory")
#define PG8_BAR __builtin_amdgcn_s_barrier()
#define PG8_SCHED __builtin_amdgcn_sched_barrier(0)
    PUnit cur, nxt; int ui = 0;
    if (!S.next(0, cur)) return;
    typedef typename Epi::acc_t acc_t;
    acc_t acc[2][2][4][2];
#pragma unroll
    for (int a = 0; a < 2; ++a)
#pragma unroll
        for (int b = 0; b < 2; ++b)
#pragma unroll
            for (int m = 0; m < 4; ++m)
#pragma unroll
                for (int n = 0; n < 2; ++n) acc[a][b][m][n] = (acc_t){0, 0, 0, 0};
    bf16x8 At[4][2], B0[2][2], B1[2][2];
    unsigned aoc[2][2], aon[2][2];
    if constexpr (Prob::GATHER) S.a_offs(cur, R, C, aoc);
    const char* cA = S.a_base(cur); const char* cB = S.b_base(cur);
    f32x4 sclv = (f32x4){0.f, 0.f, 0.f, 0.f}; PG8_SCLCALC(cur); PG8_SCLSTORE();
    {
        const char* cB0 = S.b_at(cB, cur, 0); const char* cB1 = S.b_at(cB, cur, 1);
        PG8_STAGE(PG8_SB(0, 0), cB0, voffB); PG8_STAGE(PG8_SB(0, 1), cB0 + hstepB, voffB); PG8_STAGE_A(0, 0, cA, aoc); PG8_STAGE_A(0, 1, cA, aoc);
        if (wr == 1) PG8_BAR;
        PG8_WAIT_V(2); PG8_BAR;
        PG8_STAGE(PG8_SB(1, 0), cB1, voffB); PG8_STAGE_A(1, 0, PG8_A_AT(cA, 1), aoc); PG8_STAGE(PG8_SB(1, 1), cB1 + hstepB, voffB);
        PG8_WAIT_V(6); PG8_BAR;
    }
    for (;;) {
        const bool has_next = S.next(ui + 1, nxt);
        if constexpr (Prob::GATHER) {
            if (has_next) S.a_offs(nxt, R, C, aon);
            else {
#pragma unroll
                for (int h = 0; h < 2; ++h)
#pragma unroll
                    for (int i = 0; i < 2; ++i) aon[h][i] = aoc[h][i];
            }
        }
        const char* nA = has_next ? S.a_base(nxt) : cA; const char* nB = has_next ? S.b_base(nxt) : cB;
        if constexpr (Epi::SIDE) E.side_issue(cur, lds + SIDE_OFF + (ui & 1) * 4096, wid, lane);
        for (int t = 0; t < nt; t += 2) {
            const bool last = (t == nt - 2);
            const char* a1 = PG8_A_AT(cA, t + 1);
            const char* a2 = last ? nA : PG8_A_AT(cA, t + 2); const char* b2 = last ? nB : S.b_at(cB, cur, t + 2);
            const char* a3 = last ? PG8_A_AT(nA, 1) : PG8_A_AT(cA, t + 3); const char* b3 = last ? nB + kstep : S.b_at(cB, cur, t + 3);
            if constexpr (Prob::KSC) {
                if ((0x5510u >> t) & 1u) { const int j = (t >> 1) - 3 + (t == 4 ? 1 : 0);
                    const LAS float* sp = (const LAS float*)(lds + SCLT_OFF) + (wr * 64 + fr) * 8 + j; float f[2][4];
#pragma unroll
                    for (int ai = 0; ai < 2; ++ai)
#pragma unroll
                        for (int m = 0; m < 4; ++m) f[ai][m] = sp[(ai * HALF + m * 16) * 8];
#pragma unroll
                    for (int ai = 0; ai < 2; ++ai)
#pragma unroll
                        for (int m = 0; m < 4; ++m)
#pragma unroll
                            for (int bj = 0; bj < 2; ++bj)
#pragma unroll
                                for (int n = 0; n < 2; ++n) acc[ai][bj][m][n] = acc[ai][bj][m][n] * f[ai][m]; }
            }
            PG8_LDB(B0, 0, 0); PG8_LDB(B1, 0, 1); PG8_SCHED; PG8_LDA(At, 0, 0); PG8_STAGE_A(1, 1, a1, aoc);
            if constexpr (Prob::GATHER) { if (last) {
#pragma unroll
                for (int h = 0; h < 2; ++h)
#pragma unroll
                    for (int i = 0; i < 2; ++i) aoc[h][i] = aon[h][i]; } }
            PG8_WAIT_V(8); PG8_WAIT_L(0); PG8_BAR; PG8_MMA(0, 0, At, B0); PG8_MMA(0, 1, At, B1); PG8_BAR; PG8_SCHED;
            PG8_LDA(At, 0, 1); PG8_STAGE(PG8_SB(0, 0), b2, voffB); PG8_STAGE(PG8_SB(0, 1), b2 + hstepB, voffB); PG8_STAGE_A(0, 0, a2, aoc);
            PG8_WAIT_V(8); PG8_WAIT_L(0); PG8_BAR; PG8_MMA(1, 0, At, B0); PG8_MMA(1, 1, At, B1); PG8_BAR; PG8_SCHED;
            PG8_LDB(B0, 1, 0); PG8_LDB(B1, 1, 1); PG8_SCHED; PG8_LDA(At, 1, 0); PG8_STAGE_A(0, 1, a2, aoc);
            PG8_WAIT_V(8); PG8_WAIT_L(0); PG8_BAR; PG8_MMA(0, 0, At, B0); PG8_MMA(0, 1, At, B1); PG8_BAR; PG8_SCHED;
            PG8_LDA(At, 1, 1); PG8_STAGE(PG8_SB(1, 0), b3, voffB); PG8_STAGE(PG8_SB(1, 1), b3 + hstepB, voffB); PG8_STAGE_A(1, 0, a3, aoc);
            PG8_WAIT_V(8); PG8_WAIT_L(0); PG8_BAR; PG8_MMA(1, 0, At, B0); PG8_MMA(1, 1, At, B1); PG8_BAR; PG8_SCHED;
        }
        if (wr == 0) PG8_BAR;
        if constexpr (XM & 4) {
#pragma unroll
            for (int a = 0; a < 2; ++a)
#pragma unroll
                for (int b = 0; b < 2; ++b)
#pragma unroll
                    for (int m = 0; m < 4; ++m)
#pragma unroll
                        for (int n = 0; n < 2; ++n) asm volatile("" :: "v"(acc[a][b][m][n]));
        } else { if (has_next) PG8_SCLCALC(nxt);
            if constexpr (Epi::SIDE) E(acc, cur, wr, wc, fr, fq, lds, lds + SIDE_OFF + (ui & 1) * 4096); else E(acc, cur, wr, wc, fr, fq, lds); }
        if (!has_next) break;
        if constexpr (Prob::KSC) { PG8_WAIT_L(0); PG8_BAR; }
        PG8_SCLSTORE();
#pragma unroll
        for (int a = 0; a < 2; ++a)
#pragma unroll
            for (int b = 0; b < 2; ++b)
#pragma unroll
                for (int m = 0; m < 4; ++m)
#pragma unroll
                    for (int n = 0; n < 2; ++n) acc[a][b][m][n] = (acc_t){0, 0, 0, 0};
        cur = nxt; cA = nA; cB = nB; ++ui;
        if (wr == 1) PG8_BAR;
    }
    PG8_WAIT_V(0);
    PG8_BAR;
#undef PG8_STAGE_A
#undef PG8_SCLCALC
#undef PG8_SCLSTORE
#undef PG8_A_AT
#undef PG8_SA
#undef PG8_SB
#undef PG8_STAGE
#undef PG8_LDA
#undef PG8_LDB
#undef PG8_MMA
#undef PG8_WAIT_V
#undef PG8_WAIT_L
#undef PG8_BAR
#undef PG8_SCHED
}
constexpr int CW_CNT = 8192;
constexpr int LCAP = 32768;
constexpr size_t WS_TIL = WS_PROJ;
constexpr int TBL_OFF = MISC_OFF + 128;
constexpr int PART_OFF = TBL_OFF + 256;
static_assert(PART_OFF + 4096 <= LDS_BYTES, "LDS map");

__device__ __forceinline__ void router_phase(unsigned char* ws, int l, LAS unsigned char* lds, int G) {
    int tid = threadIdx.x; asm volatile("" : "+v"(tid));
    const int lane = tid & 63, wave = __builtin_amdgcn_readfirstlane(tid >> 6);
    LAS float* lg = (LAS float*)lds + wave * 512;
    LAS int* lcnt = (LAS int*)(lds + 32768);
    const bf16* XB = (const bf16*)(ws + WS_XB); const bf16* WR = (const bf16*)(ws + WS_WR) + (size_t)l * 64 * D;
    unsigned* gcnt = (unsigned*)(ws + WS_CTL) + CW_CNT + l * 64;
    int* LIST = (int*)(ws + WS_LIST); f32x4* TIL = (f32x4*)(ws + WS_TIL);
    LAS unsigned char* WRS = lds + 40960;
    {
#pragma unroll
        for (int it = 0; it < 10; ++it) { const int idx = tid + 512 * it, row = idx >> 7, ch = idx & 127;
            *(LAS u32x4*)(WRS + row * 2064 + ch * 16) = *(const u32x4*)(WR + (size_t)(row < 20 ? row : 12 + row) * D + ch * 8); }
        if (tid < 129) { unsigned z; asm volatile("v_mov_b32 %0, 0" : "=v"(z)); *(LAS u32x4*)(WRS + 40 * 2064 + tid * 16) = (u32x4){z, z, z, z}; }
    }
    const int l15_ = lane & 15;
    const LAS unsigned char* brow[4] = { WRS + l15_ * 2064, WRS + (l15_ < 4 ? 16 + l15_ : 40) * 2064, WRS + (20 + l15_) * 2064, WRS + (l15_ < 4 ? 36 + l15_ : 40) * 2064 };
    for (int chunk = blockIdx.x; chunk < T / 128; chunk += G) {
        if (tid < 64) lcnt[tid] = 0;
        __syncthreads();
        const int tok0 = chunk * 128 + wave * 16;
        f32x4 acc[4];
#pragma unroll
        for (int i = 0; i < 4; ++i) acc[i] = (f32x4){0.f, 0.f, 0.f, 0.f};
        float ss = 0.f;
        const bf16* arow = XB + (size_t)(tok0 + (lane & 15)) * D + (lane >> 4) * 8;
        bf16x8 av[32];
#pragma unroll
        for (int ks = 0; ks < 32; ++ks) av[ks] = *(const bf16x8*)(arow + ks * 32);
#pragma unroll
        for (int ks = 0; ks < 32; ++ks) {
            const bf16x8 a = av[ks];
#pragma unroll
            for (int j = 0; j < 8; ++j) { const float v = bf2f((bf16)a[j]); ss += v * v; }
#pragma unroll
            for (int nt = 0; nt < 4; ++nt) { const bf16x8 b = *(const LAS bf16x8*)(brow[nt] + ks * 64 + (lane >> 4) * 16); acc[nt] = __builtin_amdgcn_mfma_f32_16x16x32_bf16(a, b, acc[nt], 0, 0, 0); }
        }
        ss += __shfl_xor(ss, 16); ss += __shfl_xor(ss, 32);
#pragma unroll
        for (int nt = 0; nt < 2; ++nt)
#pragma unroll
            for (int r = 0; r < 4; ++r) lg[(4 * (lane >> 4) + r) * 32 + nt * 16 + (lane & 15)] = acc[nt][r] + acc[nt + 2][r];
        LDS_WAIT(); asm volatile("" ::: "memory");
        int bucket = 0, pl = 0; float rs = 0.f, ca = 0.f, cb = 0.f;
        if (lane < 16) {
            rs = rsqrtf(ss * (1.f / D) + EPS);
            const LAS float* L = lg + lane * 32;
            const float g0 = L[0] * rs, g1 = L[1] * rs, g2 = L[2] * rs, g3 = L[3] * rs;
            int gi = 0; float mx = g0;
            if (g1 > mx) { mx = g1; gi = 1; } if (g2 > mx) { mx = g2; gi = 2; } if (g3 > mx) { mx = g3; gi = 3; }
            const float gw = 1.f / (__expf(g0 - mx) + __expf(g1 - mx) + __expf(g2 - mx) + __expf(g3 - mx));
            const LAS float* E4 = L + 4 + gi * 4;
            float e[4];
#pragma unroll
            for (int j = 0; j < 4; ++j) e[j] = E4[j] * rs;
            int i1 = 0; float m1 = e[0];
#pragma unroll
            for (int j = 1; j < 4; ++j) if (e[j] > m1) { m1 = e[j]; i1 = j; }
            int i2 = -1; float m2 = -3.0e38f;
#pragma unroll
            for (int j = 0; j < 4; ++j) if (j != i1 && e[j] > m2) { m2 = e[j]; i2 = j; }
            const float ex = __expf(m2 - m1), w1 = 1.f / (1.f + ex), w2 = ex * w1;
            const int pa = i1 < i2 ? i1 : i2, pb = i1 < i2 ? i2 : i1;
            ca = gw * (pa == i1 ? w1 : w2); cb = gw * (pa == i1 ? w2 : w1);
            const int pidx = pa == 0 ? pb - 1 : (pa == 1 ? pb + 1 : 5);
            bucket = gi * 6 + pidx;
            pl = __hip_atomic_fetch_add(lcnt + bucket, 1, __ATOMIC_RELAXED, __HIP_MEMORY_SCOPE_WORKGROUP);
        }
        __syncthreads();
        if (tid < 24) { const int c = lcnt[tid]; lcnt[32 + tid] = c ? (int)__hip_atomic_fetch_add(gcnt + tid, (unsigned)c, __ATOMIC_RELAXED, __HIP_MEMORY_SCOPE_AGENT) : 0; }
        __syncthreads();
        if (lane < 16) { const int pos = lcnt[32 + bucket] + pl, tok = tok0 + lane;
            LIST[(size_t)bucket * LCAP + pos] = tok; TIL[(size_t)bucket * LCAP + pos] = (f32x4){rs, ca, cb, 0.f}; }
        __syncthreads();
    }
}

__device__ __forceinline__ void moe_table(const unsigned* gcnt, LAS int* tbl) {
    int tid = threadIdx.x; asm volatile("" : "+v"(tid));
    if (tid < 64) {
        const int c = tid < 24 ? (int)__hip_atomic_load(gcnt + tid, __ATOMIC_RELAXED, __HIP_MEMORY_SCOPE_AGENT) : 0;
        const int tiles = (c + 255) >> 8; int s = tiles;
#pragma unroll
        for (int o = 1; o < 32; o <<= 1) { const int n = __shfl_up(s, o); if (tid >= o) s += n; }
        if (tid < 24) { tbl[tid] = s - tiles; tbl[32 + tid] = c; }
        if (tid == 23) tbl[24] = s; }
    __syncthreads();
}
struct MUnit { int pm, pn, bk, r0, nv, ea, eb; };
__device__ __forceinline__ bool moe_next(const LAS int* tbl, int stride, int c, int i0, int hi, int i, MUnit& u) {
    const int L = (i + i0) * stride + c, Rtot = __builtin_amdgcn_readfirstlane(tbl[24]);
    if (L >= 4 * Rtot || L >= hi || c < 0) return false;
    const int rt = L >> 2;
    int ln = threadIdx.x & 63; asm volatile("" : "+v"(ln));
    const int tj = tbl[ln & 31], cj = tbl[32 + (ln & 31)];
    const unsigned long long mk = __ballot(ln < 24 && tj <= rt);
    const int b = 63 - __builtin_clzll(mk | 1ull);
    const int ts = __builtin_amdgcn_readlane(tj, b), cnt = __builtin_amdgcn_readlane(cj, b);
    u.pm = rt; u.pn = L & 3; u.bk = b; u.r0 = (rt - ts) * 256; u.nv = (cnt - u.r0) < 256 ? (cnt - u.r0) : 256;
    const int g = b / 6, p = b % 6; const int a = p < 3 ? 0 : (p < 5 ? 1 : 2), bb = p < 3 ? p + 1 : (p < 5 ? p - 1 : 3);
    u.ea = g * 4 + a; u.eb = g * 4 + bb; return true;
}
struct UpProb {
    typedef MUnit Unit; static constexpr bool GATHER = true, KSC = false, I8 = false, APERM = false;
    const bf16* A; const bf16* W; const int* list; const LAS int* tbl; int K, lda, ldb, G, c, i0, hi;
    __device__ __forceinline__ bool next(int i, Unit& u) const { return moe_next(tbl, G, c, i0, hi, i, u); }
    __device__ __forceinline__ const char* a_base(const Unit&) const { return (const char*)A; }
    __device__ __forceinline__ const char* b_base(const Unit& u) const { const int e = u.pn < 2 ? u.ea : u.eb; return (const char*)W + ((size_t)e * 512 + (u.pn & 1) * 256) * D * 2; }
    __device__ __forceinline__ const char* b_at(const char* cB, const Unit&, int t) const { return cB + (size_t)t * (BK * 2); }
    __device__ __forceinline__ void a_offs(const Unit& u, const int (&R)[2], const int (&C)[2], unsigned (&off)[2][2]) const {
        const int* lp = list + (size_t)u.bk * LCAP + u.r0;
#pragma unroll
        for (int h = 0; h < 2; ++h)
#pragma unroll
            for (int i = 0; i < 2; ++i) { const int row = h * HALF + R[i]; const int tok = lp[row < u.nv ? row : 0]; off[h][i] = (unsigned)tok * (unsigned)(D * 2) + (unsigned)C[i] * 2u; }
    }
};
struct DownProb {
    typedef MUnit Unit; static constexpr bool GATHER = false, KSC = false, I8 = false, APERM = false;
    const bf16* A; const bf16* W; const LAS int* tbl; int K, lda, ldb, G, c, i0, hi;
    __device__ __forceinline__ bool next(int i, Unit& u) const { return moe_next(tbl, G, c, i0, hi, i, u); }
    __device__ __forceinline__ const char* a_base(const Unit& u) const { return (const char*)A + (size_t)u.pm * BM * 512 * 2; }
    __device__ __forceinline__ const char* b_base(const Unit& u) const { return (const char*)W + ((size_t)u.ea * D + u.pn * 256) * 256 * 2; }
    __device__ __forceinline__ const char* b_at(const char* cB, const Unit& u, int t) const { return cB + (long)t * (BK * 2) + (long)(t >> 2) * (long)((u.eb - u.ea) * (D * 256 * 2) - 512); }
    __device__ __forceinline__ void a_offs(const Unit&, const int (&)[2], const int (&)[2], unsigned (&)[2][2]) const {}
};
struct EpiHid {
    typedef f32x4 acc_t; static constexpr bool PERM = false, SIDE = true;
    bf16* H; const int* list; const f32x4* tokinfo;
    __device__ __forceinline__ void side_issue(const MUnit& u, LAS unsigned char* side, int wid, int lane) const {
        if (wid < 4) __builtin_amdgcn_global_load_lds((const unsigned*)(tokinfo + (size_t)u.bk * LCAP + u.r0 + wid * 64 + lane), (LAS unsigned*)(side + wid * 1024), 16, 0, 0);
    }
    __device__ __forceinline__ void operator()(const f32x4 (&acc)[2][2][4][2], const MUnit& u, int wr, int wc, int fr_, int fq_, LAS unsigned char*, LAS unsigned char* side) const {
        int fr = fr_, fq = fq_; asm volatile("" : "+v"(fr), "+v"(fq));
        const int hc0 = (u.pn >> 1) * 256 + (u.pn & 1) * 128 + 16 * wc + 4 * fq;
        f32x4 tiv[2][4];
#pragma unroll
        for (int ai = 0; ai < 2; ++ai)
#pragma unroll
            for (int m = 0; m < 4; ++m) { const int row = ai * HALF + wr * 64 + m * 16 + fr; tiv[ai][m] = ((const LAS f32x4*)side)[row < u.nv ? row : 0]; }
        asm volatile("" ::: "memory");
#pragma unroll
        for (int ai = 0; ai < 2; ++ai)
#pragma unroll
            for (int m = 0; m < 4; ++m) { const int row = ai * HALF + wr * 64 + m * 16 + fr; const f32x4 ti = tiv[ai][m];
                const float rs = ti[0], cw = (u.pn < 2) ? ti[1] : ti[2]; bf16* rowp = H + (size_t)(u.pm * BM + row) * 512 + hc0;
#pragma unroll
                for (int bj = 0; bj < 2; ++bj) { const f32x4 g = acc[ai][bj][m][0] * rs, up = acc[ai][bj][m][1] * (rs * cw); float h[4];
#pragma unroll
                    for (int i = 0; i < 4; ++i) h[i] = siluf(g[i]) * up[i];
                    u32x2 w; w.x = cvt_pk_bf16(h[0], h[1]); w.y = cvt_pk_bf16(h[2], h[3]); *(u32x2*)(rowp + 64 * bj) = w; }
                asm volatile("" ::: "memory"); }
    }
};
struct EpiDown {
    typedef f32x4 acc_t; static constexpr bool PERM = true, SIDE = true;
    bf16* X; const int* list; float* ssq; bool dry;
    __device__ __forceinline__ void side_issue(const MUnit& u, LAS unsigned char* side, int wid, int lane) const {
        if (wid < 4) __builtin_amdgcn_global_load_lds((const unsigned*)(list + (size_t)u.bk * LCAP + u.r0 + wid * 64 + lane), (LAS unsigned*)(side + wid * 256), 4, 0, 0);
    }
    __device__ __forceinline__ void operator()(const f32x4 (&acc)[2][2][4][2], const MUnit& u, int wr, int wc, int fr_, int fq_, LAS unsigned char* lds, LAS unsigned char* side) const {
        int fr = fr_, fq = fq_; asm volatile("" : "+v"(fr), "+v"(fq));
        const LAS int* lp = (const LAS int*)side; LAS float* part = (LAS float*)(lds + PART_OFF);
        const int col0 = u.pn * BM + wc * 32 + 8 * fq;
        int tokv[2][4]; u32x4 ov[2][4][2];
#pragma unroll
        for (int ai = 0; ai < 2; ++ai)
#pragma unroll
            for (int m = 0; m < 4; ++m) { const int row = ai * HALF + wr * 64 + m * 16 + fr; tokv[ai][m] = lp[row < u.nv ? row : 0]; }
#pragma unroll
        for (int ai = 0; ai < 2; ++ai)
#pragma unroll
            for (int m = 0; m < 4; ++m)
#pragma unroll
                for (int bj = 0; bj < 2; ++bj) ov[ai][m][bj] = *(const u32x4*)(X + (size_t)tokv[ai][m] * D + col0 + bj * HALF);
        asm volatile("" ::: "memory");
#pragma unroll
        for (int ai = 0; ai < 2; ++ai)
#pragma unroll
            for (int m = 0; m < 4; ++m) { const int row = ai * HALF + wr * 64 + m * 16 + fr; const bool valid = row < u.nv; const int tok = tokv[ai][m];
                bf16* rowp = X + (size_t)tok * D + col0; float s = 0.f;
#pragma unroll
                for (int bj = 0; bj < 2; ++bj) { const u32x4 o = ov[ai][m][bj]; const f32x4 v0 = acc[ai][bj][m][0], v1 = acc[ai][bj][m][1];
                    u32x4 w; w.x = cvt_pk_bf16(bflo(o.x) + v0[0], bfhi(o.x) + v0[1]); w.y = cvt_pk_bf16(bflo(o.y) + v0[2], bfhi(o.y) + v0[3]);
                    w.z = cvt_pk_bf16(bflo(o.z) + v1[0], bfhi(o.z) + v1[1]); w.w = cvt_pk_bf16(bflo(o.w) + v1[2], bfhi(o.w) + v1[3]);
                    if (valid && !dry) *(u32x4*)(rowp + bj * HALF) = w;
                    s += (bflo(w.x) * bflo(w.x) + bfhi(w.x) * bfhi(w.x)) + (bflo(w.y) * bflo(w.y) + bfhi(w.y) * bfhi(w.y))
                       + (bflo(w.z) * bflo(w.z) + bfhi(w.z) * bfhi(w.z)) + (bflo(w.w) * bflo(w.w) + bfhi(w.w) * bfhi(w.w)); }
                s += __shfl_xor(s, 16); s += __shfl_xor(s, 32);
                if (fq == 0) part[row * 4 + wc] = s;
                asm volatile("" ::: "memory"); }
        LDS_WAIT(); __builtin_amdgcn_s_barrier(); asm volatile("" ::: "memory");
        int row = threadIdx.x; asm volatile("" : "+v"(row));
        if (row < u.nv && !dry) { const f32x4 p = *(const LAS f32x4*)(part + row * 4); ssq[(size_t)lp[row] * 4 + u.pn] = (p[0] + p[1]) + (p[2] + p[3]); }
    }
};
__device__ __forceinline__ bf16 f2bf_hw(float v) { return (bf16)(cvt_pk_bf16(v, v) & 0xffffu); }
__device__ __forceinline__ f32x4 mfma16(bf16x8 a, bf16x8 b, f32x4 c) { return __builtin_amdgcn_mfma_f32_16x16x32_bf16(a, b, c, 0, 0, 0); }
__device__ __forceinline__ u32x4 pack8(const float (&v)[8]) { u32x4 o; o.x = cvt_pk_bf16(v[0], v[1]); o.y = cvt_pk_bf16(v[2], v[3]); o.z = cvt_pk_bf16(v[4], v[5]); o.w = cvt_pk_bf16(v[6], v[7]); return o; }
__device__ __forceinline__ bf16x8 as_frag(u32x4 v) { return __builtin_bit_cast(bf16x8, v); }
constexpr size_t DO_XW = 0, DO_QD = 32 * MiB, DO_KE = 64 * MiB, DO_VT = 96 * MiB;
constexpr size_t WS_SSQM = WS_HID, WS_SCL = WS_HID + 8 * MiB;
constexpr int P_RAW = 0, P_SC = 0, P_XST = 36864, P_BS = 73728, P_CS = 91136, P_CUM = 108544, P_DTV = 110592, P_WT = 112640;
constexpr int H_RAW = 0, H_B0 = 49152, H_BLK = 40960, H_QD = 0, H_QS = 8704, H_KS = 17408, H_VT = 26112, H_SCH = 36352;

__device__ __forceinline__ void pre_issue(u32x4 (&pr)[6], const bf16* PROJ, bool hkind, int t0, int g, int hf, int hd, int tid) {
    asm volatile("" : "+v"(tid));
#pragma unroll
    for (int it = 0; it < 6; ++it) { const int idx = tid + 512 * it;
        const int idc = idx < 35 * 64 ? idx : 35 * 64 - 1, r = idc >> 6, j = idc & 63;
        const int col = j < 32 ? 512 + g * 256 + j * 8 : (j < 48 ? 1024 + g * 128 + (j - 32) * 8 : 1280 + g * 128 + (j - 48) * 8);
        int srow = t0 + hf * 32 - 3 + r; srow = srow < 0 ? 0 : srow;
        const unsigned offr = (unsigned)srow * PW + col;
        const int mt = idx >> 10, hr = (idx >> 4) & 63, hj = idx & 15;
        const unsigned offh = (unsigned)(t0 + hr) * PW + 1536 + mt * 512 + hd * 128 + hj * 8;
        pr[it] = *(const u32x4*)(PROJ + (hkind ? offh : offr)); }
}
__device__ __forceinline__ void raw_commit(const u32x4 (&pr)[6], LAS bf16* RAW, int tid, int c, int hf) {
    asm volatile("" : "+v"(tid));
#pragma unroll
    for (int it = 0; it < 5; ++it) { const int idx = tid + 512 * it;
        if (idx < 35 * 64) { const bool z = (c == 0) && (hf * 32 - 3 + (idx >> 6) < 0);
            *(LAS u32x4*)(RAW + (idx >> 6) * 512 + (idx & 63) * 8) = z ? (u32x4){0u, 0u, 0u, 0u} : pr[it]; } }
}
__device__ __forceinline__ void hraw_commit(const u32x4 (&pr)[6], LAS bf16* HRAW, int tid) {
    asm volatile("" : "+v"(tid));
#pragma unroll
    for (int it = 0; it < 6; ++it) { const int idx = tid + 512 * it, mt = idx >> 10, r = (idx >> 4) & 63, j = idx & 15; *(LAS u32x4*)(HRAW + mt * 8192 + r * 128 + j * 8) = pr[it]; }
}

#define LBAR() do { asm volatile("s_waitcnt lgkmcnt(0)" ::: "memory"); __builtin_amdgcn_s_barrier(); asm volatile("" ::: "memory"); } while (0)
__device__ __forceinline__ void pre_phase(const Args& args, int l, LAS unsigned char* lds, int G, int mode = 7) {
    int tid = threadIdx.x; asm volatile("" : "+v"(tid));
    GAS unsigned char* wsg_ = (GAS unsigned char*)args.ws; asm volatile("" : "+s"(wsg_)); unsigned char* ws = (unsigned char*)wsg_;
    const int lane = tid & 63, wave = __builtin_amdgcn_readfirstlane(tid >> 6), q = lane >> 4, l15 = lane & 15;
    const bf16* XB = (const bf16*)(ws + WS_XB); const bf16* PROJ = (const bf16*)(ws + WS_PROJ); const bf16* WDT = (const bf16*)(ws + WS_WDT) + (size_t)l * 16 * D;
    const float* SSQ = (const float*)(ws + WS_SSQ); float* E1 = (float*)(ws + WS_E1); float* BLKDEC = (float*)(ws + WS_BLKDEC);
    bf16* YA = (bf16*)(ws + WS_YA); unsigned char* BCT = ws + WS_BCT; unsigned char* CCF = ws + WS_CC;
    unsigned char* dout = (unsigned char*)args.out; unsigned char* XWF = dout + DO_XW; unsigned char* QDF = dout + DO_QD; unsigned char* KEF = dout + DO_KE; unsigned char* VTF = dout + DO_VT;
    const float* conv_w = args.in[3] + l * 4096; const float* conv_b = args.in[4] + l * 1024; const float* dt_bias = args.in[5] + l * 8;
    const float* a_log = args.in[6] + l * 8; const float* d_skip = args.in[7] + l * 8; const float* lbl = args.in[9];
    LAS float* CUM = (LAS float*)(lds + P_CUM); LAS float* DTV = (LAS float*)(lds + P_DTV);
    LAS bf16* XST = (LAS bf16*)(lds + P_XST); LAS bf16* BS = (LAS bf16*)(lds + P_BS); LAS bf16* CS = (LAS bf16*)(lds + P_CS); LAS bf16* SC = (LAS bf16*)(lds + P_SC);
    u32x4 pr[6];
    float cwa[5], cwb[5];
    {   const int role = tid < 256 ? 0 : (tid < 384 ? 1 : 2);
        const int c0 = role == 0 ? tid : (role == 1 ? 512 + (tid - 256) : 768 + (tid - 384)), c1 = role == 0 ? 256 + tid : (role == 1 ? 512 + 128 + (tid - 256) : 768 + 128 + (tid - 384));
#pragma unroll
        for (int i = 0; i < 4; ++i) { cwa[i] = conv_w[i * 1024 + c0]; cwb[i] = conv_w[i * 1024 + c1]; }
        cwa[4] = conv_b[c0]; cwb[4] = conv_b[c1]; }
    float dska[4], dskb[4];
#pragma unroll
    for (int i = 0; i < 4; ++i) { dska[i] = d_skip[i]; dskb[i] = d_skip[4 + i]; }
    float lbh[4];
#pragma unroll
    for (int i = 0; i < 4; ++i) lbh[i] = (l == 1) ? rcpf(1.f + __expf(lbl[i * 128 + (tid & 127)] - lbl[512 + i * 128 + (tid & 127)])) : 0.f;
    const float dtb = dt_bias[wave], nega = -__expf(a_log[wave]);
    float nraw; f32x4 nssq;
    { const int u0 = (int)blockIdx.x < NB * 128 ? (int)blockIdx.x : NB * 128 - 1, ft0 = (u0 >> 7) * SEQ + (u0 & 127) * 64;
      nraw = ((const float*)(ws + WS_DT))[(size_t)(ft0 + lane) * 8 + wave]; nssq = *(const f32x4*)(SSQ + (size_t)(ft0 + lane) * 4);
      pre_issue(pr, PROJ, false, ft0, 0, 0, 0, tid); }
    for (int unit = blockIdx.x; unit < NB * 128; unit += G) {
        const int b = unit >> 7, c = unit & 127, t0 = b * SEQ + c * 64;
        if (mode & 4) {
        {   const int hh = wave, t = lane;
            const float raw = nraw;
            const float rs = rsqrtf(((nssq[0] + nssq[1]) + (nssq[2] + nssq[3])) * (1.f / D) + EPS);
            const float dtv = softplusf(raw * rs + dtb); float v = dtv * nega;
#pragma unroll
            for (int o = 1; o < 64; o <<= 1) { const float n = __shfl_up(v, o); if (lane >= o) v += n; }
            CUM[t * 8 + hh] = v; DTV[t * 8 + hh] = dtv; E1[((size_t)(t0 >> 6) * 8 + hh) * 64 + t] = __expf(v);
            ((LAS float*)(lds + P_WT))[t * 8 + hh] = __expf(__shfl(v, 63) - v) * dtv;
        }
        LBAR();
        }
        if (mode & 1)
        for (int g = 0; g < 2; ++g) {
            {
                const int role = tid < 256 ? 0 : (tid < 384 ? 1 : 2);
                const int cch = role == 0 ? g * 256 + tid : (role == 1 ? 512 + g * 128 + (tid - 256) : 768 + g * 128 + (tid - 384));
                const float w0 = g ? cwb[0] : cwa[0], w1 = g ? cwb[1] : cwa[1], w2 = g ? cwb[2] : cwa[2], w3 = g ? cwb[3] : cwa[3], cbias = g ? cwb[4] : cwa[4];
                const int h = (g * 256 + tid) >> 6;
                const LAS float* WTB = (const LAS float*)(lds + P_WT);
                LAS bf16* RAW = (LAS bf16*)(lds + P_RAW);
                for (int hf = 0; hf < 2; ++hf) {
                    raw_commit(pr, RAW, tid, c, hf);
                    pre_issue(pr, PROJ, hf == 1 && g == 1, t0, hf == 0 ? g : 1, hf == 0 ? 1 : 0, 0, tid);
                    LBAR();
                    float u0 = bf2f(RAW[tid]), u1 = bf2f(RAW[512 + tid]), u2 = bf2f(RAW[1024 + tid]);
#pragma unroll
                    for (int sq = 0; sq < 4; ++sq) {
                        const int sg = hf * 4 + sq;
                        float v[8];
#pragma unroll
                        for (int jj = 0; jj < 8; ++jj) { const float u3 = bf2f(RAW[(3 + sq * 8 + jj) * 512 + tid]);
                            const float x = cbias + w0 * u0 + w1 * u1 + w2 * u2 + w3 * u3; v[jj] = siluf(x); u0 = u1; u1 = u2; u2 = u3; }
                        u32x4 gsv = pack8(v); unsigned char* gsa = ws + WS_SCL + ((size_t)blockIdx.x * 512 + tid) * 16;
                        if (role == 0) {
                            *(LAS u32x4*)(XST + tid * 72 + sg * 8) = gsv;
                            float xw[8];
#pragma unroll
                            for (int jj = 0; jj < 8; ++jj) { const int s = sg * 8 + jj; xw[jj] = v[jj] * WTB[s * 8 + h]; }
                            const int ch = g * 256 + tid, ps = (ch & 63) >> 4;
                            gsa = XWF + (((((size_t)(b * 128 + c) * 8 + h) * 4 + ps) * 2 + (sg >> 2)) * 1024) + ((sg & 3) * 16 + (ch & 15)) * 16; gsv = pack8(xw);
                        } else if (role == 1) {
                            const int n = tid - 256;
#pragma unroll
                            for (int jj = 0; jj < 8; ++jj) BS[(sg * 8 + jj) * 136 + n] = f2bf_hw(v[jj]);
                            gsa = BCT + ((((size_t)(b * 128 + c) * 2 + g) * 16 + (n >> 4) * 2 + (sg >> 2)) * 1024) + ((sg & 3) * 16 + (n & 15)) * 16;
                        } else {
                            const int n = tid - 384;
#pragma unroll
                            for (int jj = 0; jj < 8; ++jj) CS[(sg * 8 + jj) * 136 + n] = f2bf_hw(v[jj]);
                        }
                        *(u32x4*)gsa = gsv;
                    }
                    LBAR();
                }
            }
#pragma unroll
            for (int ff = 0; ff < 2; ++ff) { const int f = wave * 2 + ff, tt = f >> 2, i = f & 3;
                const LAS bf16* row = CS + (16 * tt + l15) * 136 + 32 * i + 4 * q;
                const u32x2 lo = *(const LAS u32x2*)row, hi = *(const LAS u32x2*)(row + 16);
                *(u32x4*)(CCF + ((((size_t)(b * 128 + c) * 2 + g) * 16 + f) * 1024) + lane * 16) = (u32x4){lo.x, lo.y, hi.x, hi.y}; }
#pragma unroll
            for (int k2 = 0; k2 < 2; ++k2) { const int idx = wave * 2 + k2, ti = idx >> 2, si = idx & 3;
                f32x4 cb = (f32x4){0.f, 0.f, 0.f, 0.f};
                if (si <= ti) {
#pragma unroll
                    for (int i = 0; i < 4; ++i) cb = mfma16(*(const LAS bf16x8*)(CS + (16 * ti + l15) * 136 + 32 * i + 8 * q), *(const LAS bf16x8*)(BS + (16 * si + l15) * 136 + 32 * i + 8 * q), cb); }
                const int s = 16 * si + l15;
#pragma unroll
                for (int hh = 0; hh < 4; ++hh) { const int h = g * 4 + hh; const float cs = CUM[s * 8 + h], dts = DTV[s * 8 + h], dsk = g ? dskb[hh] : dska[hh];
#pragma unroll
                    for (int r = 0; r < 4; ++r) { const int t = 16 * ti + 4 * q + r; float val = (s <= t) ? cb[r] * __expf(CUM[t * 8 + h] - cs) * dts : 0.f; if (s == t) val += dsk;
                        SC[(hh * 64 + t) * 72 + s] = f2bf_hw(val); } }
            }
            LBAR();
#pragma unroll
            for (int k8 = 0; k8 < 8; ++k8) { const int idx = wave * 8 + k8, hh = idx >> 4, pi = (idx >> 2) & 3, ti = idx & 3;
                f32x4 acc = (f32x4){0.f, 0.f, 0.f, 0.f};
#pragma unroll
                for (int i2 = 0; i2 < 2; ++i2) if (i2 == 0 || ti >= 2)
                    acc = mfma16(*(const LAS bf16x8*)(XST + (hh * 64 + 16 * pi + l15) * 72 + 32 * i2 + 8 * q), *(const LAS bf16x8*)(SC + (hh * 64 + 16 * ti + l15) * 72 + 32 * i2 + 8 * q), acc);
                u32x2 w; w.x = cvt_pk_bf16(acc[0], acc[1]); w.y = cvt_pk_bf16(acc[2], acc[3]);
                *(u32x2*)(YA + perm_idx(t0 + 16 * ti + l15, (g * 4 + hh) * 64 + 16 * pi + 4 * q, 1024)) = w; }
            LBAR();
        }
        if (mode & 2)
        for (int hd = 0; hd < 4; ++hd) {
            {
                hraw_commit(pr, (LAS bf16*)(lds + H_RAW), tid);
                {   const int nu = unit + G < NB * 128 ? unit + G : unit;
                    const int nt0 = (nu >> 7) * SEQ + (nu & 127) * 64;
                    pre_issue(pr, PROJ, hd < 3, hd < 3 ? t0 : nt0, 0, 0, hd + 1, tid);
                    nraw = ((const float*)(ws + WS_DT))[(size_t)(nt0 + lane) * 8 + wave]; nssq = *(const f32x4*)(SSQ + (size_t)(nt0 + lane) * 4); }
            }
            LBAR();
            {
                const int bb = tid >> 8, hf = (tid >> 7) & 1, k = tid & 127, ch = hd * 128 + k, blk = c * 2 + bb;
                const float lb = hd == 0 ? lbh[0] : (hd == 1 ? lbh[1] : (hd == 2 ? lbh[2] : lbh[3]));
                const LAS bf16* pq = (const LAS bf16*)(lds + H_RAW) + (bb * 32 + hf * 16) * 128 + k; const LAS bf16* pf = pq + 8192; const LAS bf16* pi_ = pq + 16384;
                LAS unsigned char* hb = lds + H_B0 + bb * H_BLK;
                LAS bf16* QD = (LAS bf16*)(hb + H_QD); LAS bf16* QS = (LAS bf16*)(hb + H_QS); LAS bf16* KS = (LAS bf16*)(hb + H_KS); LAS bf16* VT = (LAS bf16*)(hb + H_VT);
                LAS float* EX = (LAS float*)(hb + 38912);
                float pc[16], omf[16]; float run = 1.f;
#pragma unroll
                for (int i = 0; i < 16; ++i) { const float f = lb + (1.f - lb) * sigmf(bf2f(pf[i * 128])); run *= f; pc[i] = run; omf[i] = 1.f - f; }
                EX[hf * 128 + k] = __logf(run); if (hf) EX[256 + k] = __logf(pc[0]);
                LBAR();
                const float tot0 = EX[k], tot1 = EX[128 + k], b16 = tot0 + EX[256 + k], E16 = __expf(b16), E31 = __expf(tot0 + tot1 - b16);
                const float c0 = __expf((hf ? tot0 : 0.f) - b16);
                const size_t fb = ((((size_t)(b * 256 + blk) * 4 + hd) * 8 + (k >> 4)) * 1024);
#pragma unroll
                for (int sq = 0; sq < 2; ++sq) { const int sg = hf * 2 + sq;
                    float ke[8], vv[8];
#pragma unroll
                    for (int jj = 0; jj < 8; ++jj) { const int i = sq * 8 + jj, t = hf * 16 + i;
                        const float eb = pc[i] * c0, ieb = rcpf(eb), omt = omf[i];
                        const float qv = bf2f(pq[i * 128]);
                        QD[t * 136 + k] = f2bf_hw(qv * eb * E16); QS[t * 136 + k] = f2bf_hw(qv * eb); KS[t * 136 + k] = f2bf_hw(omt * ieb);
                        ke[jj] = omt * ieb * E31; vv[jj] = bf2f(pi_[i * 128]); }
                    const u32x4 vp = pack8(vv);
                    *(u32x4*)(KEF + fb + (sg * 16 + (k & 15)) * 16) = pack8(ke);
                    *(u32x4*)(VTF + fb + (sg * 16 + (k & 15)) * 16) = vp;
                    *(LAS u32x4*)(VT + k * 40 + sg * 8) = vp;
                }
                if (hf == 0) BLKDEC[(size_t)(b * 256 + blk) * 512 + ch] = E16 * E31;
            }
            LBAR();
            {
                const int bb = wave >> 2, ti = (wave >> 1) & 1, si = wave & 1; LAS unsigned char* hb = lds + H_B0 + bb * H_BLK;
                const LAS bf16* QS = (const LAS bf16*)(hb + H_QS); const LAS bf16* KS = (const LAS bf16*)(hb + H_KS); LAS bf16* SCH = (LAS bf16*)(hb + H_SCH);
                f32x4 sc = (f32x4){0.f, 0.f, 0.f, 0.f};
                if (si <= ti) {
#pragma unroll
                    for (int i = 0; i < 4; ++i) sc = mfma16(*(const LAS bf16x8*)(QS + (16 * ti + l15) * 136 + 32 * i + 8 * q), *(const LAS bf16x8*)(KS + (16 * si + l15) * 136 + 32 * i + 8 * q), sc); }
                const int s = 16 * si + l15;
#pragma unroll
                for (int r = 0; r < 4; ++r) { const int t = 16 * ti + 4 * q + r; SCH[t * 40 + s] = f2bf_hw(s <= t ? sc[r] : 0.f); }
            }
#pragma unroll
            for (int ff = 0; ff < 2; ++ff) { const int f = wave * 2 + ff, bb = f >> 3, tt = (f >> 2) & 1, i = f & 3;
                const LAS bf16* row = (const LAS bf16*)(lds + H_B0 + bb * H_BLK + H_QD) + (16 * tt + l15) * 136 + 32 * i + 4 * q;
                const u32x2 lo = *(const LAS u32x2*)row, hi = *(const LAS u32x2*)(row + 16);
                *(u32x4*)(QDF + ((((size_t)(b * 256 + c * 2 + bb) * 4 + hd) * 8 + tt * 4 + i) * 1024) + lane * 16) = (u32x4){lo.x, lo.y, hi.x, hi.y}; }
            LBAR();
#pragma unroll
            for (int k4 = 0; k4 < 4; ++k4) { const int idx = wave * 4 + k4, bb = idx >> 4, vi = (idx >> 1) & 7, ti = idx & 1; LAS unsigned char* hb = lds + H_B0 + bb * H_BLK;
                const f32x4 acc = mfma16(*(const LAS bf16x8*)((const LAS bf16*)(hb + H_VT) + (16 * vi + l15) * 40 + 8 * q), *(const LAS bf16x8*)((const LAS bf16*)(hb + H_SCH) + (16 * ti + l15) * 40 + 8 * q), (f32x4){0.f, 0.f, 0.f, 0.f});
                u32x2 w; w.x = cvt_pk_bf16(acc[0], acc[1]); w.y = cvt_pk_bf16(acc[2], acc[3]);
                *(u32x2*)(YA + perm_idx(t0 + bb * 32 + 16 * ti + l15, 512 + hd * 128 + 16 * vi + 4 * q, 1024)) = w; }
            LBAR();
        }
    }
}

constexpr int SQ_SLOT = 43008, SQ_R = 3, SQ_NP = 39;
constexpr int SQ_EX = 135936;
__device__ __forceinline__ void seq_issue(const unsigned char* const (&pb)[7], const int (&stride)[7], const int (&dstp)[7], int cidx, LAS unsigned char* slot, bool small38, bool has7) {
#pragma unroll
    for (int k = 0; k < 7; ++k) {
        if (k == 6 && !has7) continue;
        if (k == 6 && small38) __builtin_amdgcn_global_load_lds((const unsigned*)(pb[k] + (size_t)cidx * stride[k]), (LAS unsigned*)(slot + dstp[k] * 1024), 4, 0, 0);
        else __builtin_amdgcn_global_load_lds((const unsigned*)(pb[k] + (size_t)cidx * stride[k]), (LAS unsigned*)(slot + dstp[k] * 1024), 16, 0, 0); }
}
__device__ __forceinline__ void seq_phase(const Args& args, LAS unsigned char* lds, int G, int vb, bool dry = false, bool nocompute = false, int xm = 0) {
    int tid = threadIdx.x; asm volatile("" : "+v"(tid));
    GAS unsigned char* wsg_ = (GAS unsigned char*)args.ws; asm volatile("" : "+s"(wsg_)); unsigned char* ws = (unsigned char*)wsg_;
    const int lane = tid & 63, wave = __builtin_amdgcn_readfirstlane(tid >> 6), q = lane >> 4, l15 = lane & 15;
    unsigned char* dout = (unsigned char*)args.out;
    bf16* YA = (bf16*)(ws + WS_YA); float* SSQM = (float*)(ws + WS_SSQM);
    for (int task = vb; task < 256; task += G) {
        const int xc = task & 7, si = task >> 3;
        const bool ssd = si < 16;
        int b = xc >> 1, hh, sl;
        if (ssd) { hh = (xc & 1) * 4 + (si >> 2); sl = si & 3; } else { hh = (xc & 1) * 2 + ((si - 16) >> 3); sl = si & 7; }
        const int ycol = ssd ? hh * 64 + sl * 16 : 512 + hh * 128 + sl * 16;
        const int gcol = ssd ? hh * 64 + sl * 16 : 3072 + hh * 128 + sl * 16;
        __syncthreads();
        if (wave >= 2) {
            int ln = lane; asm volatile("" : "+v"(ln));
            const unsigned char* pb[7]; int stride[7]; int dstp[7];
#pragma unroll
            for (int k = 0; k < 7; ++k) {
                int p = (wave - 2) + 6 * k; dstp[k] = p; if (p >= SQ_NP) p -= 6;
            const unsigned char* base; int st;
            if (ssd) {
                const int g = hh >> 2;
                if (p < 16)      { base = ws + WS_CC  + (((size_t)(b * 128) * 2 + g) * 16 + p) * 1024 + ln * 16; st = 2 * 16 * 1024; }
                else if (p < 32) { base = ws + WS_BCT + (((size_t)(b * 128) * 2 + g) * 16 + (p - 16)) * 1024 + ln * 16; st = 2 * 16 * 1024; }
                else if (p < 34) { base = dout + DO_XW + ((((size_t)(b * 128) * 8 + hh) * 4 + sl) * 2 + (p - 32)) * 1024 + ln * 16; st = 8 * 4 * 2 * 1024; }
                else if (p < 36) { base = ws + WS_YA + perm_idx(b * SEQ + ln, ycol + 8 * (p - 34), 1024) * 2; st = 64 * 1024 * 2; }
                else if (p < 38) { base = ws + WS_PROJ + perm_idx(b * SEQ + ln, gcol + 8 * (p - 36), PW) * 2; st = 64 * PW * 2; }
                else             { base = ws + WS_E1 + (((size_t)(b * 128) * 8 + hh) * 64 + ln) * 4; st = 8 * 64 * 4; }
            } else {
                if (p < 16)      { base = dout + DO_QD + ((((size_t)(b * 256) + (p >> 3)) * 4 + hh) * 8 + (p & 7)) * 1024 + ln * 16; st = 2 * 4 * 8 * 1024; }
                else if (p < 32) { base = dout + DO_KE + ((((size_t)(b * 256) + ((p - 16) >> 3)) * 4 + hh) * 8 + ((p - 16) & 7)) * 1024 + ln * 16; st = 2 * 4 * 8 * 1024; }
                else if (p < 34) { base = dout + DO_VT + ((((size_t)(b * 256) + (p - 32)) * 4 + hh) * 8 + sl) * 1024 + ln * 16; st = 2 * 4 * 8 * 1024; }
                else if (p < 36) { base = ws + WS_YA + perm_idx(b * SEQ + ln, ycol + 8 * (p - 34), 1024) * 2; st = 64 * 1024 * 2; }
                else if (p < 38) { base = ws + WS_PROJ + perm_idx(b * SEQ + ln, gcol + 8 * (p - 36), PW) * 2; st = 64 * PW * 2; }
                else             { base = ws + WS_BLKDEC + ((size_t)(b * 256 + (ln >> 5)) * 512 + hh * 128 + 4 * (ln & 31)) * 4; st = 2 * 512 * 4; }
            }
            if (xm == 1 && p >= 34) { base = ws + WS_CC + (((size_t)(b * 128) * 2 + (hh >> 2 & 1)) * 16 + (p - 34)) * 1024 + ln * 16; st = 2 * 16 * 1024; }
            if (xm == 2 && p < 34) { base = ws + WS_YA + ((size_t)(b * SEQ + ln) * 1024 + ycol + 8 * (p & 1)) * 2; st = 64 * 1024 * 2; }
            pb[k] = base; stride[k] = st;
            }
            const bool small38 = ssd && wave == 4;
            const bool has7 = wave < 5;
            seq_issue(pb, stride, dstp, 0, lds, small38, has7);
            seq_issue(pb, stride, dstp, 1, lds + SQ_SLOT, small38, has7);
            for (int c = 0; c < 128; ++c) {
                if (c < 127) { if (has7) asm volatile("s_waitcnt vmcnt(7)" ::: "memory"); else asm volatile("s_waitcnt vmcnt(6)" ::: "memory"); } else asm volatile("s_waitcnt vmcnt(0)" ::: "memory");
                __builtin_amdgcn_s_barrier(); asm volatile("" ::: "memory");
                if (c + 2 < 128) seq_issue(pb, stride, dstp, c + 2, lds + ((c + 2) % SQ_R) * SQ_SLOT, small38, has7);
                if (!nocompute) __builtin_amdgcn_s_barrier();
            }
        } else {
            const int h = wave;
            f32x4 X[4];
#pragma unroll
            for (int j = 0; j < 4; ++j) X[j] = (f32x4){0.f, 0.f, 0.f, 0.f};
            for (int c = 0; c < 128; ++c) {
                __builtin_amdgcn_s_barrier(); asm volatile("" ::: "memory");
                if (nocompute) continue;
                const LAS unsigned char* L = lds + (c % SQ_R) * SQ_SLOT;
                const int t0 = b * SEQ + c * 64;
                if (ssd) {
                    LAS unsigned char* exw = lds + SQ_EX + h * 2048; const LAS unsigned char* exr = lds + SQ_EX + (1 - h) * 2048;
                    bf16x8 F[8], Gf[8];
#pragma unroll
                    for (int tt = 0; tt < 4; ++tt)
#pragma unroll
                        for (int ii = 0; ii < 2; ++ii) F[tt * 2 + ii] = *(const LAS bf16x8*)(L + (tt * 4 + 2 * h + ii) * 1024 + lane * 16);
                    u32x2 ya[2], zz[2]; float e1[2];
#pragma unroll
                    for (int k = 0; k < 2; ++k) { const int t = 16 * (2 * h + k) + l15;
                        e1[k] = *(const LAS float*)(L + 38 * 1024 + t * 4);
                        ya[k] = *(const LAS u32x2*)(L + (34 + (q >> 1)) * 1024 + t * 16 + (q & 1) * 8);
                        zz[k] = *(const LAS u32x2*)(L + (36 + (q >> 1)) * 1024 + t * 16 + (q & 1) * 8); }
                    const float cdec = *(const LAS float*)(L + 38 * 1024 + 63 * 4);
#pragma unroll
                    for (int p = 0; p < 8; ++p) Gf[p] = *(const LAS bf16x8*)(L + (16 + 8 * h + p) * 1024 + lane * 16);
                    const bf16x8 xw0 = *(const LAS bf16x8*)(L + 32 * 1024 + lane * 16), xw1 = *(const LAS bf16x8*)(L + 33 * 1024 + lane * 16);
                    bf16x8 af[2];
#pragma unroll
                    for (int i = 0; i < 2; ++i) { u32x4 w; w.x = cvt_pk_bf16(X[2 * i][0], X[2 * i][1]); w.y = cvt_pk_bf16(X[2 * i][2], X[2 * i][3]);
                        w.z = cvt_pk_bf16(X[2 * i + 1][0], X[2 * i + 1][1]); w.w = cvt_pk_bf16(X[2 * i + 1][2], X[2 * i + 1][3]); af[i] = as_frag(w); }
                    __builtin_amdgcn_sched_barrier(0);
                    f32x4 yi[4];
#pragma unroll
                    for (int tt = 0; tt < 4; ++tt) yi[tt] = mfma16(af[0], F[tt * 2], (f32x4){0.f, 0.f, 0.f, 0.f});
#pragma unroll
                    for (int tt = 0; tt < 4; ++tt) yi[tt] = mfma16(af[1], F[tt * 2 + 1], yi[tt]);
#pragma unroll
                    for (int k = 0; k < 2; ++k) *(LAS f32x4*)(exw + k * 1024 + lane * 16) = h ? yi[k] : yi[2 + k];
#pragma unroll
                    for (int j = 0; j < 4; ++j) X[j] = mfma16(Gf[j * 2], xw0, X[j] * cdec);
#pragma unroll
                    for (int j = 0; j < 4; ++j) X[j] = mfma16(Gf[j * 2 + 1], xw1, X[j]);
                    asm volatile("s_waitcnt lgkmcnt(0)" ::: "memory"); __builtin_amdgcn_s_barrier(); asm volatile("" ::: "memory");
#pragma unroll
                    for (int k = 0; k < 2; ++k) { const int tt = 2 * h + k, t = 16 * tt + l15;
                        const f32x4 yo = (h ? yi[2 + k] : yi[k]) + *(const LAS f32x4*)(exr + k * 1024 + lane * 16);
                        const float yv[4] = {bflo(ya[k].x), bfhi(ya[k].x), bflo(ya[k].y), bfhi(ya[k].y)}; const float zv[4] = {bflo(zz[k].x), bfhi(zz[k].x), bflo(zz[k].y), bfhi(zz[k].y)};
                        float o[4], s = 0.f;
#pragma unroll
                        for (int r = 0; r < 4; ++r) { o[r] = (yv[r] + e1[k] * yo[r]) * siluf(zv[r]); s += o[r] * o[r]; }
                        u32x2 w; w.x = cvt_pk_bf16(o[0], o[1]); w.y = cvt_pk_bf16(o[2], o[3]);
                        if (!dry) *(u32x2*)(YA + perm_idx(t0 + t, ycol + 4 * q, 1024)) = w; else asm volatile("" :: "v"(w.x), "v"(w.y));
                        s += __shfl_xor(s, 16); s += __shfl_xor(s, 32);
                        if (q == 0 && !dry) SSQM[(size_t)(hh * 4 + sl) * T + t0 + t] = s; }
                } else {
                    LAS unsigned char* exw = lds + SQ_EX + h * 2048; const LAS unsigned char* exr = lds + SQ_EX + (1 - h) * 2048;
                    f32x4 mine[2]; u32x2 yav[2], zzv[2];
#pragma unroll
                    for (int bb = 0; bb < 2; ++bb) {
                        bf16x8 F[4], Gf[4]; f32x4 dec[4];
#pragma unroll
                        for (int tt = 0; tt < 2; ++tt)
#pragma unroll
                            for (int ii = 0; ii < 2; ++ii) F[tt * 2 + ii] = *(const LAS bf16x8*)(L + (bb * 8 + tt * 4 + 2 * h + ii) * 1024 + lane * 16);
                        const int t = bb * 32 + 16 * h + l15;
                        yav[bb] = *(const LAS u32x2*)(L + (34 + (q >> 1)) * 1024 + t * 16 + (q & 1) * 8); zzv[bb] = *(const LAS u32x2*)(L + (36 + (q >> 1)) * 1024 + t * 16 + (q & 1) * 8);
#pragma unroll
                        for (int p = 0; p < 4; ++p) { Gf[p] = *(const LAS bf16x8*)(L + (16 + bb * 8 + 4 * h + p) * 1024 + lane * 16); dec[p] = *(const LAS f32x4*)(L + 38 * 1024 + (bb * 32 + 4 * (4 * h + p) + q) * 16); }
                        const bf16x8 vt = *(const LAS bf16x8*)(L + (32 + bb) * 1024 + lane * 16);
                        bf16x8 af[2];
#pragma unroll
                        for (int i = 0; i < 2; ++i) { u32x4 w; w.x = cvt_pk_bf16(X[2 * i][0], X[2 * i][1]); w.y = cvt_pk_bf16(X[2 * i][2], X[2 * i][3]);
                            w.z = cvt_pk_bf16(X[2 * i + 1][0], X[2 * i + 1][1]); w.w = cvt_pk_bf16(X[2 * i + 1][2], X[2 * i + 1][3]); af[i] = as_frag(w); }
                        __builtin_amdgcn_sched_barrier(0);
                        f32x4 oi[2];
#pragma unroll
                        for (int tt = 0; tt < 2; ++tt) oi[tt] = mfma16(af[0], F[tt * 2], (f32x4){0.f, 0.f, 0.f, 0.f});
#pragma unroll
                        for (int tt = 0; tt < 2; ++tt) oi[tt] = mfma16(af[1], F[tt * 2 + 1], oi[tt]);
                        *(LAS f32x4*)(exw + bb * 1024 + lane * 16) = h ? oi[0] : oi[1];
                        mine[bb] = h ? oi[1] : oi[0];
#pragma unroll
                        for (int j = 0; j < 4; ++j) X[j] = mfma16(Gf[j], vt, X[j] * dec[j]);
                        __builtin_amdgcn_sched_barrier(0);
                    }
                    asm volatile("s_waitcnt lgkmcnt(0)" ::: "memory"); __builtin_amdgcn_s_barrier(); asm volatile("" ::: "memory");
#pragma unroll
                    for (int bb = 0; bb < 2; ++bb) { const int t = bb * 32 + 16 * h + l15;
                        const f32x4 ot = mine[bb] + *(const LAS f32x4*)(exr + bb * 1024 + lane * 16);
                        const float yv[4] = {bflo(yav[bb].x), bfhi(yav[bb].x), bflo(yav[bb].y), bfhi(yav[bb].y)}; const float zv[4] = {bflo(zzv[bb].x), bfhi(zzv[bb].x), bflo(zzv[bb].y), bfhi(zzv[bb].y)};
                        float o[4], s = 0.f;
#pragma unroll
                        for (int r = 0; r < 4; ++r) { const float ov = yv[r] + ot[r]; s += ov * ov; o[r] = ov * siluf(zv[r]); }
                        u32x2 w; w.x = cvt_pk_bf16(o[0], o[1]); w.y = cvt_pk_bf16(o[2], o[3]);
                        if (!dry) *(u32x2*)(YA + perm_idx(t0 + t, ycol + 4 * q, 1024)) = w; else asm volatile("" :: "v"(w.x), "v"(w.y));
                        s += __shfl_xor(s, 16); s += __shfl_xor(s, 32);
                        if (q == 0 && !dry) SSQM[(size_t)(32 + hh * 8 + sl) * T + t0 + t] = s; }
                }
            }
        }
        __syncthreads();
    }
}

__device__ __forceinline__ void norm_phase(const Args& args, int l, int G) {
    int tid = threadIdx.x; asm volatile("" : "+v"(tid));
    GAS unsigned char* wsg_ = (GAS unsigned char*)args.ws; asm volatile("" : "+s"(wsg_)); unsigned char* ws = (unsigned char*)wsg_;
    const int lane = tid & 63, wave = __builtin_amdgcn_readfirstlane(tid >> 6);
    const float* SSQM = (const float*)(ws + WS_SSQM); float* SCL = (float*)(ws + WS_SCL);
    for (int t0 = blockIdx.x * NWAVES + wave; t0 < T; t0 += 4 * G * NWAVES) {
        float pp[4];
#pragma unroll
        for (int r = 0; r < 4; ++r) { const int t = t0 + r * G * NWAVES; pp[r] = SSQM[(size_t)(t < T ? t : t0) * 64 + lane]; }
#pragma unroll
        for (int r = 0; r < 4; ++r) { const int t = t0 + r * G * NWAVES; float p = pp[r];
        p += __shfl_xor(p, 1); p += __shfl_xor(p, 2); p += __shfl_xor(p, 4);
        const float p8 = p; p += __shfl_xor(p, 8);
        const float sumS = __shfl(p, (lane & 1) * 16), sumH = __shfl(p8, 32 + ((lane - 2) & 3) * 8);
        const float sc = lane < 2 ? rsqrtf(sumS * (1.f / 256.f) + EPS) : rsqrtf(sumH * (1.f / 128.f) + EPS);
        const float nx = __shfl(sc, (lane + 1) & 63);
        const float o = lane < 5 ? sc * rcpf(nx) : (lane == 5 ? sc : 0.f);
        if (lane < 8 && t < T) SCL[(size_t)t * 8 + lane] = o; }
    }
}
#define XB_TMO      128
#define XB_XCNT(j)  (256  + 64 * (j))
#define XB_XSUB(j)  (1280 + 64 * (j))
#define XB_XGEN(j)  (2304 + 64 * (j))
#define XB_TOP      3328
#define XB_TOPGEN   3392
#define XCD_BAR_WORDS 3456
#define XB_SPIN_CAP (1u << 24)
__device__ __forceinline__ unsigned xb_ld(unsigned* p)              { return __hip_atomic_load(p, __ATOMIC_RELAXED, __HIP_MEMORY_SCOPE_AGENT); }
__device__ __forceinline__ unsigned xb_add(unsigned* p, unsigned v) { return __hip_atomic_fetch_add(p, v, __ATOMIC_RELAXED, __HIP_MEMORY_SCOPE_AGENT); }
__device__ __forceinline__ unsigned xb_xcc_id() { return (unsigned)__builtin_amdgcn_s_getreg((3 << 11) | 20) & 0xFu; }
#define XB_SPIN(cond, bar) do { unsigned _sp = 0; while (cond) { \
    if ((++_sp & 255u) == 0u) { if (xb_ld(&(bar)[XB_TMO])) break; if (_sp > XB_SPIN_CAP) { atomicAdd(&(bar)[XB_TMO], 1u); break; } } } } while (0)
struct XcdBarrier { unsigned* bar; unsigned x; volatile LAS unsigned* st; };
__device__ __forceinline__ XcdBarrier xcd_barrier_post(unsigned* bar, volatile LAS unsigned* st) {
    XcdBarrier b; b.bar = bar; b.x = xb_xcc_id(); b.st = st;
    if (threadIdx.x == 0) st[2] = xb_add(&bar[XB_XCNT(b.x)], 1u);
    return b;
}
__device__ __forceinline__ void xcd_barrier_complete(unsigned* bar, unsigned x, unsigned& nloc, unsigned& nx) {
    const unsigned G = gridDim.x * gridDim.y * gridDim.z;
    unsigned sum, cnt, mine, sp = 0u;
    for (;;) {
        sum = 0u; cnt = 0u; mine = 0u;
#pragma unroll
        for (unsigned j = 0; j < 16; ++j) { const unsigned c = xb_ld(&bar[XB_XCNT(j)]); sum += c; cnt += (c > 0u) ? 1u : 0u; mine = (j == x) ? c : mine; }
        if (sum == G) break;
        if ((++sp & 255u) == 0u) { if (xb_ld(&bar[XB_TMO])) break; if (sp > XB_SPIN_CAP) { atomicAdd(&bar[XB_TMO], 1u); break; } }
    }
    nloc = mine > 0u ? mine : 1u; nx = cnt > 0u ? cnt : 1u;
}
__device__ __forceinline__ void xcd_barrier(const XcdBarrier& b) {
    asm volatile("s_waitcnt vmcnt(0)" ::: "memory");
    __syncthreads();
    if (threadIdx.x == 0) {
        unsigned* bar = b.bar;
        __builtin_amdgcn_s_waitcnt(0);
        unsigned nloc = b.st[0], nx = b.st[1];
        if (nloc == 0u) { xcd_barrier_complete(bar, b.x, nloc, nx); b.st[0] = nloc; b.st[1] = nx; }
        const unsigned old = xb_add(&bar[XB_XSUB(b.x)], 1u);
        const unsigned gen = old / nloc;
        if (old + 1u == (gen + 1u) * nloc) {
            __builtin_amdgcn_fence(__ATOMIC_RELEASE, "agent");
            asm volatile("s_waitcnt vmcnt(0)" ::: "memory");
            xb_add(&bar[XB_TOP], 1u);
        }
        XB_SPIN(xb_ld(&bar[XB_TOP]) < (gen + 1u) * nx, bar);
        __builtin_amdgcn_fence(__ATOMIC_ACQUIRE, "agent");
        asm volatile("s_waitcnt vmcnt(0)" ::: "memory");
    }
    __syncthreads();
}

constexpr int CW_MFLAG = 9216, MFLAG_WORDS = 1152;
__device__ __forceinline__ void mflag_arrive(unsigned* w, const XcdBarrier& b) {
    asm volatile("s_waitcnt vmcnt(0)" ::: "memory");
    __syncthreads();
    if (threadIdx.x == 0) {
        const unsigned nloc = b.st[0], nx = b.st[1];
        const unsigned old = xb_add(&w[64 * b.x], 1u);
        if (old + 1u == nloc) {
            __builtin_amdgcn_fence(__ATOMIC_RELEASE, "agent");
            asm volatile("s_waitcnt vmcnt(0)" ::: "memory");
            xb_add(&w[1024], 1u);
        }
    }
}
__device__ __forceinline__ void mflag_arrive2(unsigned* wa, unsigned* wb, const XcdBarrier& b) {
    asm volatile("s_waitcnt vmcnt(0)" ::: "memory");
    __syncthreads();
    if (threadIdx.x == 0) {
        const unsigned nloc = b.st[0];
        const unsigned oa = xb_add(&wa[64 * b.x], 1u), ob = xb_add(&wb[64 * b.x], 1u);
        const bool la = oa + 1u == nloc, lb = ob + 1u == nloc;
        if (la || lb) {
            __builtin_amdgcn_fence(__ATOMIC_RELEASE, "agent");
            asm volatile("s_waitcnt vmcnt(0)" ::: "memory");
            if (la) xb_add(&wa[1024], 1u);
            if (lb) xb_add(&wb[1024], 1u);
        }
    }
}
__device__ __forceinline__ void mflag_wait(unsigned* w, const XcdBarrier& b) {
    if (threadIdx.x == 0) {
        unsigned* bar = b.bar;
        const unsigned nx = b.st[1];
        XB_SPIN(xb_ld(&w[1024]) < nx, bar);
        __builtin_amdgcn_fence(__ATOMIC_ACQUIRE, "agent");
        asm volatile("s_waitcnt vmcnt(0)" ::: "memory");
    }
    __syncthreads();
}

constexpr int CW_BAR = 4096;

__device__ __forceinline__ unsigned pk2(float lo, float hi) { return (unsigned)f2bf(lo) | ((unsigned)f2bf(hi) << 16); }

__device__ __forceinline__ unsigned q8pack(float a, float b, float c, float d) {
    const float M = 12582912.f;
    const unsigned ya = __float_as_uint(a + M), yb = __float_as_uint(b + M), yc = __float_as_uint(c + M), yd = __float_as_uint(d + M);
    return __builtin_amdgcn_perm(yb, ya, 0x0c0c0400u) | __builtin_amdgcn_perm(yd, yc, 0x04000c0cu);
}
template <class Src>
__device__ __forceinline__ void tr_item(const Src& src, bf16* WT, int ldk, int row0, int k0, LAS float* scr, int lane) {
    const int kr = lane >> 3, c4 = lane & 7;
    f32x4 v[8]; float sc[8];
#pragma unroll
    for (int i = 0; i < 8; ++i) { v[i] = src.ld4(k0 + kr + 8 * i, c4); sc[i] = src.scale(k0 + kr + 8 * i); }
#pragma unroll
    for (int i = 0; i < 8; ++i) { LAS float* d = scr + (kr + 8 * i) * 33 + 4 * c4; const f32x4 x = v[i] * sc[i]; d[0] = x[0]; d[1] = x[1]; d[2] = x[2]; d[3] = x[3]; }
    LDS_WAIT(); asm volatile("" ::: "memory");
    const int c = lane & 7;
#pragma unroll
    for (int j = 0; j < 4; ++j) { const int n = (lane >> 3) + 8 * j; const LAS float* s = scr + (8 * c) * 33 + n;
        u32x4 o; o.x = pk2(s[0 * 33], s[1 * 33]); o.y = pk2(s[2 * 33], s[3 * 33]); o.z = pk2(s[4 * 33], s[5 * 33]); o.w = pk2(s[6 * 33], s[7 * 33]);
        *(u32x4*)(WT + (size_t)(row0 + n) * ldk + k0 + 8 * c) = o; }
    LDS_WAIT(); asm volatile("" ::: "memory");
}
struct SrcWin { const float* w; const float* nw; int nb;
    __device__ __forceinline__ float operator()(int k, int j) const { const int np = nb * 32 + j; return w[(size_t)k * INW + (np < 1536 ? np : np + 8)] * nw[k]; } };
struct SrcWout { const float* w; int n0; const float* snw; const float* hnw;
    __device__ __forceinline__ f32x4 ld4(int k, int c4) const { return *(const f32x4*)(w + (size_t)k * D + n0 + 4 * c4); }
    __device__ __forceinline__ float scale(int k) const { return k < 512 ? snw[k] : hnw[k - 512]; } };
struct SrcPlain { const float* w; int ldn, n0;
    __device__ __forceinline__ f32x4 ld4(int k, int c4) const { return *(const f32x4*)(w + (size_t)k * ldn + n0 + 4 * c4); }
    __device__ __forceinline__ float scale(int) const { return 1.f; } };
struct SrcGU { const float* wg; const float* wu; const float* nw; int grp;
    __device__ __forceinline__ f32x4 ld4(int k, int c4) const { const unsigned long long pa = c4 < 4 ? (unsigned long long)wg : (unsigned long long)wu;
        return *(const f32x4*)((const float*)pa + (size_t)k * 256 + grp * 16 + (c4 & 3) * 4); }
    __device__ __forceinline__ float scale(int k) const { return nw[k]; } };

constexpr int CW_COLMAX = 65536;
constexpr int IT_WIN = 16 * 112, IT_WOUT = 16 * 32, IT_WGU = 16 * 16 * 16, IT_WD = 16 * 4 * 32, IT_LAYER = IT_WIN + IT_WOUT + IT_WGU + IT_WD;
__device__ __forceinline__ float reduce8(const float (&p)[8], int lane) {
    float a[4], b[2], c;
#pragma unroll
    for (int i = 0; i < 4; ++i) { const bool up = (lane & 32) != 0; const float keep = up ? p[i + 4] : p[i], send = up ? p[i] : p[i + 4]; a[i] = keep + __shfl_xor(send, 32); }
#pragma unroll
    for (int i = 0; i < 2; ++i) { const bool up = (lane & 16) != 0; const float keep = up ? a[i + 2] : a[i], send = up ? a[i] : a[i + 2]; b[i] = keep + __shfl_xor(send, 16); }
    { const bool up = (lane & 8) != 0; const float keep = up ? b[1] : b[0], send = up ? b[0] : b[1]; c = keep + __shfl_xor(send, 8); }
    c += __shfl_xor(c, 4); c += __shfl_xor(c, 2); c += __shfl_xor(c, 1);
    return c;
}
typedef __bf16 bf16x2v __attribute__((ext_vector_type(2)));
__device__ __forceinline__ float dot2bf(unsigned a, unsigned b, float c) { return __builtin_amdgcn_fdot2_f32_bf16(__builtin_bit_cast(bf16x2v, a), __builtin_bit_cast(bf16x2v, b), c, false); }
constexpr int P0_WDT = 73728;
__device__ __forceinline__ void p0_prep(const Args& a, LAS unsigned char* lds, int G) {
    const int tid = threadIdx.x, lane = tid & 63, wave = __builtin_amdgcn_readfirstlane(tid >> 6);
    LAS float* scr = (LAS float*)(lds + wave * 8448);
    const int gw = blockIdx.x * NWAVES + wave, NGW = G * NWAVES;
    unsigned char* ws = a.ws;
    {
        LAS bf16* WL = (LAS bf16*)(lds + P0_WDT);
#pragma unroll
        for (int kk = 0; kk < 2; ++kk) { const int k = tid + 512 * kk; const f32x4 w0 = *(const f32x4*)(a.in[2] + (size_t)k * INW + 1536), w1 = *(const f32x4*)(a.in[2] + (size_t)k * INW + 1540); const float nw = a.in[1][k];
            WL[0 * 1024 + k] = f2bf(w0[0] * nw); WL[1 * 1024 + k] = f2bf(w0[1] * nw); WL[2 * 1024 + k] = f2bf(w0[2] * nw); WL[3 * 1024 + k] = f2bf(w0[3] * nw);
            WL[4 * 1024 + k] = f2bf(w1[0] * nw); WL[5 * 1024 + k] = f2bf(w1[1] * nw); WL[6 * 1024 + k] = f2bf(w1[2] * nw); WL[7 * 1024 + k] = f2bf(w1[3] * nw); }
        __syncthreads();
    }
    for (int cb = blockIdx.x; cb < 2 * 112; cb += G) {
        const int l = cb / 112, nb = cb % 112;
        SrcWin s{a.in[2] + (size_t)l * D * INW, a.in[1] + l * D, nb};
        float tv[2][32]; float mx = 0.f;
#pragma unroll
        for (int q = 0; q < 2; ++q)
#pragma unroll
            for (int i = 0; i < 32; ++i) { tv[q][i] = s((2 * wave + q) * 64 + 2 * i + (lane >> 5), lane & 31); mx = fmaxf(mx, fabsf(tv[q][i])); }
        mx = fmaxf(mx, __shfl_xor(mx, 32));
        LAS float* CMX = (LAS float*)(lds + P0_WDT + 16384);
        if (lane < 32) CMX[wave * 32 + lane] = mx;
        __syncthreads();
        const int n = lane >> 1, half = lane & 1;
        float cm = 0.f;
#pragma unroll
        for (int w = 0; w < 8; ++w) cm = fmaxf(cm, CMX[w * 32 + n]);
        const float inv = cm > 0.f ? 127.f / cm : 0.f;
#pragma unroll
        for (int q = 0; q < 2; ++q) { const int kb = 2 * wave + q;
#pragma unroll
            for (int i = 0; i < 32; ++i) { const int kk = 2 * i + (lane >> 5); scr[kk * 33 + (lane & 31)] = tv[q][i]; }
            LDS_WAIT(); asm volatile("" ::: "memory");
            const LAS float* sp = scr + (half * 32) * 33 + n;
            u32x4 o0, o1;
            o0.x = q8pack(sp[0 * 33] * inv, sp[1 * 33] * inv, sp[2 * 33] * inv, sp[3 * 33] * inv);     o0.y = q8pack(sp[4 * 33] * inv, sp[5 * 33] * inv, sp[6 * 33] * inv, sp[7 * 33] * inv);
            o0.z = q8pack(sp[8 * 33] * inv, sp[9 * 33] * inv, sp[10 * 33] * inv, sp[11 * 33] * inv);   o0.w = q8pack(sp[12 * 33] * inv, sp[13 * 33] * inv, sp[14 * 33] * inv, sp[15 * 33] * inv);
            o1.x = q8pack(sp[16 * 33] * inv, sp[17 * 33] * inv, sp[18 * 33] * inv, sp[19 * 33] * inv); o1.y = q8pack(sp[20 * 33] * inv, sp[21 * 33] * inv, sp[22 * 33] * inv, sp[23 * 33] * inv);
            o1.z = q8pack(sp[24 * 33] * inv, sp[25 * 33] * inv, sp[26 * 33] * inv, sp[27 * 33] * inv); o1.w = q8pack(sp[28 * 33] * inv, sp[29 * 33] * inv, sp[30 * 33] * inv, sp[31 * 33] * inv);
            unsigned char* dst = ws + WS_WIN + ((size_t)l * PW + nb * 32 + n) * D + kb * 64 + half * 32;
            *(u32x4*)dst = o0; *(u32x4*)(dst + 16) = o1;
            LDS_WAIT(); asm volatile("" ::: "memory"); }
        if (wave == 0 && half == 0) ((float*)(ws + WS_CS))[l * PW + nb * 32 + n] = cm * (1.f / 127.f);
        __syncthreads();
    }
    for (int it = gw; it < 2 * (IT_LAYER - IT_WIN); it += NGW) {
        const int l = it / (IT_LAYER - IT_WIN); int r = it % (IT_LAYER - IT_WIN);
        if (r < IT_WOUT) { const int kb = r / 32, nb = r % 32; SrcWout s{a.in[11] + (size_t)l * D * D, nb * 32, a.in[8] + l * 512, a.in[10] + l * 512};
            tr_item(s, (bf16*)(ws + WS_WOUT) + (size_t)l * D * D, D, nb * 32, kb * 64, scr, lane); continue; } r -= IT_WOUT;
        if (r < IT_WGU) { const int e = r / 256, kb = (r % 256) / 16, grp = r % 16; const size_t eo = ((size_t)l * 16 + e) * D * 256;
            SrcGU s{a.in[15] + eo, a.in[16] + eo, a.in[12] + l * D, grp};
            tr_item(s, (bf16*)(ws + WS_WGU) + ((size_t)l * 16 + e) * 512 * D, D, grp * 32, kb * 64, scr, lane); continue; } r -= IT_WGU;
        { const int e = r / 128, kb = (r % 128) / 32, nb = r % 32; SrcPlain s{a.in[17] + ((size_t)l * 16 + e) * 256 * D, D, nb * 32};
            tr_item(s, (bf16*)(ws + WS_WD) + ((size_t)l * 16 + e) * D * 256, 256, nb * 32, kb * 64, scr, lane); }
    }
    for (int i = blockIdx.x * NTHR + tid; i < 2 * 64 * D; i += G * NTHR) {
        const int l = i / (64 * D), row = (i / D) % 64, k = i % D, c = row & 31; float v = 0.f;
        if (c < 4) v = a.in[13][((size_t)l * D + k) * 4 + c] * a.in[12][l * D + k];
        else if (c < 20) v = a.in[14][((size_t)l * D + k) * 16 + (c - 4)] * a.in[12][l * D + k];
        const bf16 hi = f2bf(v); const bf16 o = (row < 32) ? hi : f2bf(v - bf2f(hi));
        ((bf16*)(ws + WS_WR))[i] = o;
    }
    for (int i = blockIdx.x * NTHR + tid; i < 2 * 16 * D; i += G * NTHR) {
        const int l = i / (16 * D), row = (i / D) % 16, k = i % D;
        const float v = row < 8 ? a.in[2][((size_t)l * D + k) * INW + 1536 + row] * a.in[1][l * D + k] : 0.f;
        ((bf16*)(ws + WS_WDT))[i] = f2bf(v);
    }
    bf16* XB = (bf16*)(ws + WS_XB); float* SSQ = (float*)(ws + WS_SSQ);
    unsigned* XQ = (unsigned*)(ws + WS_XQ); float* SA = (float*)(ws + WS_SA);
    for (int m0 = gw; m0 < T; m0 += 4 * NGW) {
        f32x4 v[4][4];
#pragma unroll
        for (int r = 0; r < 4; ++r) { const int m = m0 + r * NGW; const f32x4* xr = (const f32x4*)(a.in[0] + (size_t)(m < T ? m : m0) * D) + lane;
#pragma unroll
            for (int j = 0; j < 4; ++j) v[r][j] = xr[64 * j]; }
#pragma unroll
        for (int r = 0; r < 4; ++r) { const int m = m0 + r * NGW; float s = 0.f, mx = 0.f;
            unsigned long long* o8 = (unsigned long long*)(XB + (size_t)(m < T ? m : m0) * D) + lane;
            float qv[4][4]; unsigned xlo[4], xhi[4];
#pragma unroll
            for (int j = 0; j < 4; ++j) { const unsigned lo = cvt_pk_bf16(v[r][j][0], v[r][j][1]), hi = cvt_pk_bf16(v[r][j][2], v[r][j][3]); xlo[j] = lo; xhi[j] = hi;
                const float q0 = bflo(lo), q1 = bfhi(lo), q2 = bflo(hi), q3 = bfhi(hi); s += (q0 * q0 + q1 * q1) + (q2 * q2 + q3 * q3);
                qv[j][0] = q0; qv[j][1] = q1; qv[j][2] = q2; qv[j][3] = q3; mx = fmaxf(fmaxf(mx, fmaxf(fabsf(q0), fabsf(q1))), fmaxf(fabsf(q2), fabsf(q3)));
                if (m < T) o8[64 * j] = (unsigned long long)lo | ((unsigned long long)hi << 32); }
            s = wave_sum(s);
#pragma unroll
            for (int o = 1; o < 64; o <<= 1) mx = fmaxf(mx, __shfl_xor(mx, o));
            const float inv = mx > 0.f ? 127.f / mx : 0.f;
            if (m < T) {
#pragma unroll
                for (int j = 0; j < 4; ++j) XQ[(size_t)m * 256 + lane + 64 * j] = q8pack(qv[j][0] * inv, qv[j][1] * inv, qv[j][2] * inv, qv[j][3] * inv);
                if (lane < 4) SSQ[(size_t)m * 4 + lane] = lane == 0 ? s : 0.f;
                if (lane == 0) SA[m] = mx * (1.f / 127.f) * rsqrtf(s * (1.f / D) + EPS); }
            float dp[8];
#pragma unroll
            for (int h = 0; h < 8; ++h) { dp[h] = 0.f;
#pragma unroll
                for (int j = 0; j < 4; ++j) { const u32x2 w = *(const LAS u32x2*)(lds + P0_WDT + (h * 1024 + 4 * (lane + 64 * j)) * 2);
                    dp[h] = dot2bf(xhi[j], w.y, dot2bf(xlo[j], w.x, dp[h])); } }
            const float dtot = reduce8(dp, lane);
            if (m < T && (lane & 7) == 0) ((float*)(ws + WS_DT))[(size_t)m * 8 + (lane >> 3)] = dtot; }
    }
}

__device__ __forceinline__ void p1_quant_win(const Args& a, LAS unsigned char* lds, int G) {
    int tid = threadIdx.x; asm volatile("" : "+v"(tid));
    const int lane = tid & 63, wave = __builtin_amdgcn_readfirstlane(tid >> 6);
    LAS float* scr = (LAS float*)(lds + wave * 16384);
    const int gw = blockIdx.x * NWAVES + wave, NGW = G * NWAVES;
    unsigned char* ws = a.ws;
    for (int it = gw; it < 2 * IT_WIN; it += NGW) {
        const int l = it / IT_WIN, r = it % IT_WIN, kb = r / 112, nb = r % 112;
        SrcWin s{a.in[2] + (size_t)l * D * INW, a.in[1] + l * D, nb};
#pragma unroll 8
        for (int i = 0; i < 32; ++i) { const int kk = 2 * i + (lane >> 5); scr[kk * 33 + (lane & 31)] = s(kb * 64 + kk, lane & 31); }
        LDS_WAIT(); asm volatile("" ::: "memory");
        const int n = lane >> 1, half = lane & 1;
        const float cm = __uint_as_float(__hip_atomic_load((unsigned*)(ws + WS_CTL) + CW_COLMAX + l * 4096 + nb * 32 + n, __ATOMIC_RELAXED, __HIP_MEMORY_SCOPE_AGENT));
        const float inv = cm > 0.f ? 127.f / cm : 0.f;
        const LAS float* sp = scr + (half * 32) * 33 + n;
        u32x4 o0, o1;
        o0.x = q8pack(sp[0 * 33] * inv, sp[1 * 33] * inv, sp[2 * 33] * inv, sp[3 * 33] * inv);     o0.y = q8pack(sp[4 * 33] * inv, sp[5 * 33] * inv, sp[6 * 33] * inv, sp[7 * 33] * inv);
        o0.z = q8pack(sp[8 * 33] * inv, sp[9 * 33] * inv, sp[10 * 33] * inv, sp[11 * 33] * inv);   o0.w = q8pack(sp[12 * 33] * inv, sp[13 * 33] * inv, sp[14 * 33] * inv, sp[15 * 33] * inv);
        o1.x = q8pack(sp[16 * 33] * inv, sp[17 * 33] * inv, sp[18 * 33] * inv, sp[19 * 33] * inv); o1.y = q8pack(sp[20 * 33] * inv, sp[21 * 33] * inv, sp[22 * 33] * inv, sp[23 * 33] * inv);
        o1.z = q8pack(sp[24 * 33] * inv, sp[25 * 33] * inv, sp[26 * 33] * inv, sp[27 * 33] * inv); o1.w = q8pack(sp[28 * 33] * inv, sp[29 * 33] * inv, sp[30 * 33] * inv, sp[31 * 33] * inv);
        unsigned char* dst = ws + WS_WIN + ((size_t)l * PW + nb * 32 + n) * D + kb * 64 + half * 32;
        *(u32x4*)dst = o0; *(u32x4*)(dst + 16) = o1;
        if (kb == 0 && half == 0) ((float*)(ws + WS_CS))[l * PW + nb * 32 + n] = cm * (1.f / 127.f);
        LDS_WAIT(); asm volatile("" ::: "memory");
    }
}
__device__ __forceinline__ void quant_rows(const Args& a, LAS unsigned char* lds, int G) {
    int tid = threadIdx.x; asm volatile("" : "+v"(tid));
    {
        const u32x4* src = (const u32x4*)(a.ws + WS_WDT + (size_t)16 * D * 2);
#pragma unroll
        for (int kk = 0; kk < 2; ++kk) *(LAS u32x4*)(lds + P0_WDT + (tid + 512 * kk) * 16) = src[tid + 512 * kk];
        __syncthreads();
    }
    GAS unsigned char* wsg_ = (GAS unsigned char*)a.ws; asm volatile("" : "+s"(wsg_)); unsigned char* ws = (unsigned char*)wsg_;
    const int lane = tid & 63, wave = __builtin_amdgcn_readfirstlane(tid >> 6);
    const bf16* XB = (const bf16*)(ws + WS_XB); unsigned char* XQ = ws + WS_XQ; float* SA = (float*)(ws + WS_SA); const float* SSQ = (const float*)(ws + WS_SSQ);
    for (int t0 = blockIdx.x * NWAVES + wave; t0 < T; t0 += 4 * G * NWAVES) {
        u32x4 x0[4], x1[4]; f32x4 sq[4];
#pragma unroll
        for (int r = 0; r < 4; ++r) { const int t = t0 + r * G * NWAVES, tt = t < T ? t : t0; x0[r] = *(const u32x4*)(XB + (size_t)tt * D + lane * 8); x1[r] = *(const u32x4*)(XB + (size_t)tt * D + 512 + lane * 8); sq[r] = *(const f32x4*)(SSQ + (size_t)tt * 4); }
#pragma unroll
        for (int r = 0; r < 4; ++r) { const int t = t0 + r * G * NWAVES;
            const float v[16] = {bflo(x0[r].x), bfhi(x0[r].x), bflo(x0[r].y), bfhi(x0[r].y), bflo(x0[r].z), bfhi(x0[r].z), bflo(x0[r].w), bfhi(x0[r].w), bflo(x1[r].x), bfhi(x1[r].x), bflo(x1[r].y), bfhi(x1[r].y), bflo(x1[r].z), bfhi(x1[r].z), bflo(x1[r].w), bfhi(x1[r].w)};
            float mx = 0.f;
#pragma unroll
            for (int i = 0; i < 16; ++i) mx = fmaxf(mx, fabsf(v[i]));
#pragma unroll
            for (int o = 1; o < 64; o <<= 1) mx = fmaxf(mx, __shfl_xor(mx, o));
            const float inv = mx > 0.f ? 127.f / mx : 0.f;
            if (t < T) { u32x2 q0, q1; q0.x = q8pack(v[0] * inv, v[1] * inv, v[2] * inv, v[3] * inv); q0.y = q8pack(v[4] * inv, v[5] * inv, v[6] * inv, v[7] * inv);
                q1.x = q8pack(v[8] * inv, v[9] * inv, v[10] * inv, v[11] * inv); q1.y = q8pack(v[12] * inv, v[13] * inv, v[14] * inv, v[15] * inv);
                *(u32x2*)(XQ + (size_t)t * D + lane * 8) = q0; *(u32x2*)(XQ + (size_t)t * D + 512 + lane * 8) = q1;
                if (lane == 0) SA[t] = mx * (1.f / 127.f) * rsqrtf(((sq[r][0] + sq[r][1]) + (sq[r][2] + sq[r][3])) * (1.f / D) + EPS); }
            float dp[8];
#pragma unroll
            for (int h = 0; h < 8; ++h) { const u32x4 w0 = *(const LAS u32x4*)(lds + P0_WDT + (h * 1024 + lane * 8) * 2), w1 = *(const LAS u32x4*)(lds + P0_WDT + (h * 1024 + 512 + lane * 8) * 2);
                dp[h] = dot2bf(x0[r].x, w0.x, dot2bf(x0[r].y, w0.y, dot2bf(x0[r].z, w0.z, dot2bf(x0[r].w, w0.w, 0.f)))) + dot2bf(x1[r].x, w1.x, dot2bf(x1[r].y, w1.y, dot2bf(x1[r].z, w1.z, dot2bf(x1[r].w, w1.w, 0.f)))); }
            const float dtot = reduce8(dp, lane);
            if (t < T && (lane & 7) == 0) ((float*)(ws + WS_DT))[(size_t)t * 8 + (lane >> 3)] = dtot; }
    }
}

enum { PH_PREP = 0, PH_L0 = 1, PHL_INPROJ = 0, PHL_PRE = 1, PHL_SEQ = 2, PHL_NORM = 3, PHL_OUTPROJ = 4, PHL_ROUTER = 5, PHL_UP = 6, PHL_DOWN = 7, PHL_COUNT = 8, PH_FINAL = PH_L0 + 2 * PHL_COUNT, PH_COUNT = PH_FINAL + 1 };

__global__ void __launch_bounds__(NTHR, 2) mega(Args args) {
    extern __shared__ __attribute__((aligned(16))) unsigned char lds_raw[];
    LAS unsigned char* lds = (LAS unsigned char*)lds_raw;
    const int G = gridDim.x;
    for (int u = threadIdx.x; u < (LDS_BYTES - LDSCTL_OFF) / 4; u += NTHR) ((LAS unsigned*)(lds + LDSCTL_OFF))[u] = 0u;
    __syncthreads();
    const int lo = args.ph_lo, hi = args.ph_hi;
    XcdBarrier bar; bar.bar = (unsigned*)(args.ws + WS_CTL) + CW_BAR + args.li * XCD_BAR_WORDS; bar.x = 0; bar.st = nullptr;
    if (hi - lo > 1) bar = xcd_barrier_post(bar.bar, (volatile LAS unsigned*)(lds + MISC_OFF) + 8);
#ifndef PHMASK
#define PHMASK 0xffffffffu
#endif
#ifndef SEQX
#define SEQX 0
#endif
#ifndef SEQNC
#define SEQNC true
#endif
#ifndef DUPMASK
#define DUPMASK 0u
#endif
#define DUP(bit) ((DUPMASK >> (bit)) & 1u)
#define IN(k) (lo <= (k) && (k) < hi)
#define ON(bit) ((PHMASK >> (bit)) & 1u)
#define SEAM(k) do { if (IN(k) && IN((k) + 1)) xcd_barrier(bar); } while (0)
#define OPAQUE_WS() GAS unsigned char* wsg_ = (GAS unsigned char*)args.ws; asm volatile("" : "+s"(wsg_)); unsigned char* ws = (unsigned char*)wsg_
    if (DUP(0) && IN(PH_PREP)) { p0_prep(args, lds, G); xcd_barrier(bar); }
    if (ON(0) && IN(PH_PREP)) { p0_prep(args, lds, G); }
    SEAM(PH_PREP);
    int vb = (int)blockIdx.x;
    if (IN(PH_PREP) && IN(PH_PREP + 1)) {
        volatile LAS unsigned* st = (volatile LAS unsigned*)(lds + MISC_OFF) + 8;
        if (threadIdx.x == 0) { bool ok = (G == 256);
            unsigned cn[16];
#pragma unroll
            for (unsigned j = 0; j < 16; ++j) cn[j] = xb_ld(&bar.bar[XB_XCNT(j)]);
#pragma unroll
            for (unsigned j = 0; j < 16; ++j) ok &= (j < 8 ? cn[j] == 32u : cn[j] == 0u);
            st[3] = (ok && bar.x < 8u && st[2] < 32u) ? (bar.x + 8u * st[2]) : blockIdx.x; }
        __syncthreads();
        vb = __builtin_amdgcn_readfirstlane((int)st[3]);
    }
    for (int l = 0; l < 2; ++l) {
        const int pb = PH_L0 + l * PHL_COUNT;
        for (int rep = DUP(1) ? 0 : 1; rep < 2; ++rep)
        if (ON(1) && IN(pb + PHL_INPROJ)) { OPAQUE_WS(); if (rep == 1 && DUP(1)) xcd_barrier(bar);
            if (l == 1) { quant_rows(args, lds, G); xcd_barrier(bar); }
            I8Prob P; P.A = (const bf16*)(ws + WS_XQ); P.Bt = (const bf16*)(ws + WS_WIN + (size_t)l * PW * D); P.K = D / 2; P.lda = D / 2; P.ldb = D / 2; P.so.init(T, PW, G, vb);
            EpiProjI8 E{(bf16*)(ws + WS_PROJ), PW, (const float*)(ws + WS_SA), (const float*)(ws + WS_CS) + l * PW, false, false};
#ifndef XMODE
#define XMODE 0
#endif
            if (DUP(1) && rep == 0) { EpiProjI8 E2 = E; E2.nostore = (XMODE & 8) != 0; E2.dense = (XMODE & 16) != 0; gemm_phase<EpiProjI8, I8Prob, XMODE>(lds, P, E2); } else
            gemm_phase<EpiProjI8, I8Prob>(lds, P, E);
        }
        SEAM(pb + PHL_INPROJ);
        #ifndef PREMODE
#define PREMODE 7
#endif
        if (DUP(6) && IN(pb + PHL_PRE)) { pre_phase(args, l, lds, G, PREMODE); xcd_barrier(bar); }
        if (ON(6) && IN(pb + PHL_PRE)) pre_phase(args, l, lds, G);
        SEAM(pb + PHL_PRE);
        if (DUP(7) && IN(pb + PHL_SEQ)) { seq_phase(args, lds, G, vb, true, SEQNC, SEQX); xcd_barrier(bar); }
        if (ON(7) && IN(pb + PHL_SEQ)) seq_phase(args, lds, G, vb);
        SEAM(pb + PHL_SEQ);
        for (int rep = DUP(2) ? 0 : 1; rep < 2; ++rep)
        if (ON(2) && IN(pb + PHL_OUTPROJ)) { OPAQUE_WS(); if (rep == 1 && DUP(2)) xcd_barrier(bar);
            PlainProbT<true, true> P; P.A = (const bf16*)(ws + WS_YA); P.Bt = (const bf16*)(ws + WS_WOUT) + (size_t)l * D * D; P.K = D; P.lda = D; P.ldb = D; P.so.init(T, D, G, vb);
            P.scl = (const float*)(ws + WS_SSQM);
            EpiResid E{(bf16*)(ws + WS_XB), D, rep == 0, (const float*)(ws + WS_SCL)};
            gemm_phase<EpiResid, PlainProbT<true, true>>(lds, P, E);
        }
        SEAM(pb + PHL_OUTPROJ);
        if (ON(3) && IN(pb + PHL_ROUTER)) { OPAQUE_WS(); router_phase(ws, l, lds, G); }
        SEAM(pb + PHL_ROUTER);
        if (ON(4) && IN(pb + PHL_UP) && IN(pb + PHL_DOWN)) { OPAQUE_WS();
            LAS int* tbl = (LAS int*)(lds + TBL_OFF); moe_table((const unsigned*)(ws + WS_CTL) + CW_CNT + l * 64, tbl);
            unsigned* fl = (unsigned*)(ws + WS_CTL) + CW_MFLAG + l * 2 * MFLAG_WORDS;
            const int n = 4 * __builtin_amdgcn_readfirstlane(tbl[24]);
            const int vm = ((G & 7) == 0) ? (vb & 7) * (G >> 3) + (vb >> 3) : vb;
            {   UpProb P; P.A = (const bf16*)(ws + WS_XB); P.W = (const bf16*)(ws + WS_WGU) + (size_t)l * 16 * 512 * D; P.list = (const int*)(ws + WS_LIST); P.tbl = tbl;
                P.K = D; P.lda = D; P.ldb = D; P.G = G; P.c = vm;
                EpiHid E{(bf16*)(ws + WS_HID), (const int*)(ws + WS_LIST), (const f32x4*)(ws + WS_TIL)};
                const bool third = 2 * G + vm < n;
                P.i0 = 0; P.hi = 2 * G;
                gemm_phase<EpiHid, UpProb>(lds, P, E);
                if (!third) mflag_arrive2(fl, fl + MFLAG_WORDS, bar);
                else { mflag_arrive(fl, bar);
                    P.i0 = 2; P.hi = 0x7fffffff;
                    gemm_phase<EpiHid, UpProb>(lds, P, E);
                    mflag_arrive(fl + MFLAG_WORDS, bar); }
            }
            {   int c0 = n - 2 * G; c0 = c0 < 0 ? 0 : c0; if (c0 >= G) c0 = 0;
                const int Gd = G - c0, cd = vm - c0;
                DownProb P; P.A = (const bf16*)(ws + WS_HID); P.W = (const bf16*)(ws + WS_WD) + (size_t)l * 16 * D * 256; P.tbl = tbl;
                P.K = 512; P.lda = 512; P.ldb = 256; P.G = Gd; P.c = cd;
                EpiDown E{(bf16*)(ws + WS_XB), (const int*)(ws + WS_LIST), (float*)(ws + WS_SSQ), false};
                for (int part = 0; part < 2; ++part) {
                    const int ifirst = cd >= 0 ? (2 * G - cd + Gd - 1) / Gd : 0;
                    P.i0 = part ? (ifirst < 0 ? 0 : ifirst) : 0; P.hi = part ? 0x7fffffff : 2 * G;
                    if (cd >= 0) mflag_wait(fl + part * MFLAG_WORDS, bar);
                    gemm_phase<EpiDown, DownProb>(lds, P, E);
                }
            }
        }
        SEAM(pb + PHL_DOWN);
    }
    if (IN(PH_FINAL)) {
        OPAQUE_WS(); int tid = threadIdx.x; asm volatile("" : "+v"(tid));
        const int lane = tid & 63, wave = __builtin_amdgcn_readfirstlane(tid >> 6);
        const bf16* XB = (const bf16*)(ws + WS_XB); const float* fw = args.in[18];
        float w[16];
#pragma unroll
        for (int j = 0; j < 2; ++j)
#pragma unroll
            for (int i = 0; i < 8; ++i) w[j * 8 + i] = fw[j * 512 + lane * 8 + i];
        for (int t0 = blockIdx.x * NWAVES + wave; t0 < T; t0 += 4 * G * NWAVES) {
            u32x4 a[4], b[4];
#pragma unroll
            for (int r = 0; r < 4; ++r) { const int t = t0 + r * G * NWAVES, tt = t < T ? t : t0; a[r] = *(const u32x4*)(XB + (size_t)tt * D + lane * 8); b[r] = *(const u32x4*)(XB + (size_t)tt * D + 512 + lane * 8); }
#pragma unroll
            for (int r = 0; r < 4; ++r) { const int t = t0 + r * G * NWAVES;
                float v[16] = {bflo(a[r].x), bfhi(a[r].x), bflo(a[r].y), bfhi(a[r].y), bflo(a[r].z), bfhi(a[r].z), bflo(a[r].w), bfhi(a[r].w), bflo(b[r].x), bfhi(b[r].x), bflo(b[r].y), bfhi(b[r].y), bflo(b[r].z), bfhi(b[r].z), bflo(b[r].w), bfhi(b[r].w)};
                float s = 0.f;
#pragma unroll
                for (int i = 0; i < 16; ++i) s += v[i] * v[i];
                s = rsqrtf(wave_sum(s) * (1.f / D) + EPS);
                if (t < T) { float* o = args.out + (size_t)t * D + lane * 8;
                    *(f32x4*)(o) = (f32x4){v[0] * s * w[0], v[1] * s * w[1], v[2] * s * w[2], v[3] * s * w[3]};
                    *(f32x4*)(o + 4) = (f32x4){v[4] * s * w[4], v[5] * s * w[5], v[6] * s * w[6], v[7] * s * w[7]};
                    *(f32x4*)(o + 512) = (f32x4){v[8] * s * w[8], v[9] * s * w[9], v[10] * s * w[10], v[11] * s * w[11]};
                    *(f32x4*)(o + 516) = (f32x4){v[12] * s * w[12], v[13] * s * w[13], v[14] * s * w[14], v[15] * s * w[15]}; } }
        }
    }
#undef IN
#undef SEAM
}
extern "C" void kernel_launch(void* const* d_in, const int* in_sizes, int n_in, void* d_out, int out_size, void* d_ws, size_t ws_size, hipStream_t stream) {
    static int grid = 0;
    if (grid == 0) {
        int dev = 0, cus = 0;
        if (hipGetDevice(&dev) != hipSuccess || hipDeviceGetAttribute(&cus, hipDeviceAttributeMultiprocessorCount, dev) != hipSuccess) { fprintf(stderr, "kernel_launch: device query failed\n"); grid = -1; return; }
        if (hipFuncSetAttribute((const void*)mega, hipFuncAttributeMaxDynamicSharedMemorySize, LDS_BYTES) != hipSuccess) { fprintf(stderr, "kernel_launch: hipFuncSetAttribute failed\n"); grid = -1; return; }
        int nb = 0;
        if (hipOccupancyMaxActiveBlocksPerMultiprocessor(&nb, mega, NTHR, (size_t)LDS_BYTES) != hipSuccess || nb < 1) { fprintf(stderr, "kernel_launch: occupancy query: kernel cannot be resident\n"); grid = -1; return; }
        (void)hipGetLastError();
        grid = cus;
    }
    if (grid < 0) return;
    unsigned char* ws = (unsigned char*)d_ws;
    (void)hipMemsetAsync(ws + WS_CTL, 0, CTL_ZERO_BYTES, stream);
    Args a{};
    for (int i = 0; i < 19; ++i) a.in[i] = (const float*)d_in[i];
    a.out = (float*)d_out; a.ws = ws;
    auto run = [&](int lo, int hi, int li) { a.ph_lo = lo; a.ph_hi = hi; a.li = li; hipLaunchKernelGGL(mega, dim3(grid), dim3(NTHR), LDS_BYTES, stream, a); };
    run(PH_PREP, PH_COUNT, 0);
}
```
